# Optimizing an MI355X kernel written in HIP

```python
import math
import jax, jax.numpy as jnp
from jax import lax
import numpy as np

D_MODEL = 2048
BATCH = 8
SEQ = 4096
DEPTH = 1

GRID_W = 64
CTX_LEN = 256
D_FF = 5632
N_MOD = 9
EPS = 1e-6
HG_WIDTH = D_MODEL // 2
HG_HEADS = 8
HG_DK = HG_WIDTH // HG_HEADS
HG_DV = HG_WIDTH // HG_HEADS
CHUNK = 64
HY_WIDTH = D_MODEL - HG_WIDTH
FILT_EMB = 33
FILT_ORDER = 64
DECAY_TARGET = 1e-2
DECAY_FAST_PCT = 0.3
DECAY_SLOW_PCT = 1.5
COL_Q = 3 * HG_WIDTH
COL_G = 4 * HG_WIDTH
COL_HY = 5 * HG_WIDTH
IN_COLS = 5 * HG_WIDTH + 3 * HY_WIDTH

kernel_name = 'hybrid_hgrn2_hyena_macaron_dit'

F32 = jnp.float32


def _rmsnorm(x, g):
    xf = x.astype(F32)
    y = xf * lax.rsqrt(jnp.mean(xf * xf, axis=-1, keepdims=True) + EPS)
    return (y * g.astype(F32)).astype(x.dtype)


def _modulate(h, shift, scale):
    return h * (1 + scale) + shift


def _swiglu(h, w1, w3, w2):
    return (jax.nn.silu(h @ w1) * (h @ w3)) @ w2


def _flip(a):
    return jnp.flip(a, axis=1)


def _heads(a):
    return a.reshape(a.shape[:-1] + (HG_HEADS, a.shape[-1] // HG_HEADS))


def _hgrn_gates(a, lb):
    a = a.astype(F32)
    logf = jnp.log(lb + (1 - lb) * jax.nn.sigmoid(a))
    k = (1 - lb) * jax.nn.sigmoid(-a)
    return _heads(k), _heads(logf)


def _hgrn_inputs(p, lb):
    k_f, g_f = _hgrn_gates(p[..., :HG_WIDTH], lb[0])
    k_b, g_b = _hgrn_gates(p[..., HG_WIDTH:2 * HG_WIDTH], lb[1])
    v = _heads(p[..., 2 * HG_WIDTH:COL_Q].astype(F32))
    return k_f, g_f, k_b, g_b, v


def _query(p):
    return _heads(p[..., COL_Q:COL_G].astype(F32)) * (HG_DK ** -0.5)


def _hgrn_scan(q, k, v, logf, s0):
    bsz, n, h, _ = q.shape
    dv = v.shape[-1]
    nc = n // CHUNK

    def to_chunks(a):
        return a.reshape(bsz, nc, CHUNK, h, a.shape[-1]).transpose(1, 0, 3, 2, 4)

    lower_tri = jnp.tril(jnp.ones((CHUNK, CHUNK), dtype=bool))[:, :, None]

    def step(s, inp):
        qc, kc, vc, gc = inp
        b = jnp.cumsum(gc, axis=2)
        o = jnp.einsum('bhtk,bhkv->bhtv', qc * jnp.exp(b), s)
        rel = jnp.exp(jnp.where(lower_tri, b[:, :, :, None, :] - b[:, :, None, :, :], -jnp.inf))
        scores = jnp.einsum('bhtk,bhtsk,bhsk->bhts', qc, rel, kc)
        o = o + jnp.einsum('bhts,bhsv->bhtv', scores, vc)
        b_end = b[:, :, -1:, :]
        s = jnp.exp(b_end[:, :, 0, :, None]) * s + jnp.einsum('bhsk,bhsv->bhkv', kc * jnp.exp(b_end - b), vc)
        return s, o

    s_fin, o = lax.scan(step, s0, (to_chunks(q), to_chunks(k), to_chunks(v), to_chunks(logf)))
    o = o.transpose(1, 0, 3, 2, 4).reshape(bsz, n, h, dv)
    return o, s_fin


def _final_state(k, v, logf):
    cum = jnp.cumsum(logf, axis=1)
    return jnp.einsum('blhk,blhv->bhkv', k * jnp.exp(cum[:, -1:] - cum), v)


def _bidir_hgrn(q, k_f, g_f, k_b, g_b, v, s_f, s_b):
    o_f, s_f = _hgrn_scan(q, k_f, v, g_f, s_f)
    o_b, s_b = _hgrn_scan(_flip(q), _flip(k_b), _flip(v), _flip(g_b), s_b)
    return o_f + _flip(o_b), s_f, s_b


def _hgrn_readout(o, g, gain):
    o = o * lax.rsqrt(jnp.mean(o * o, axis=-1, keepdims=True) + EPS) * gain.astype(F32).reshape(HG_HEADS, HG_DV)
    o = o.reshape(o.shape[:2] + (HG_WIDTH,))
    return (o * jax.nn.silu(g.astype(F32))).astype(g.dtype)


def _short_conv(u, w, b, on_grid):
    shape = u.shape
    if on_grid:
        rows = shape[1] // GRID_W
        u = u.reshape(shape[0], rows, GRID_W, shape[2])
    pad = [(0, 0)] * (u.ndim - 2) + [(1, 1), (0, 0)]
    up = jnp.pad(u, pad)
    y = up[..., :-2, :] * w[0] + up[..., 1:-1, :] * w[1] + up[..., 2:, :] * w[2] + b
    return y.reshape(shape)


def _hyena_spectrum(n, w1, b1, w2, b2, w3, b3, freq, w_out):
    w1, b1, w2, b2, w3, b3, freq, w_out = [a.astype(F32) for a in (w1, b1, w2, b2, w3, b3, freq, w_out)]
    pos = jnp.arange(n, dtype=F32)
    t = pos / max(n - 1, 1)
    bands = (FILT_EMB - 1) // 2
    fb = jnp.linspace(1e-4, bands - 1, bands, dtype=F32)
    ang = (2 * math.pi / n) * pos[:, None] * fb[None, :]
    z = jnp.concatenate([t[:, None], jnp.cos(ang), -jnp.sin(ang)], axis=-1)
    hid = jnp.sin(freq * (z @ w1 + b1))
    hid = jnp.sin(freq * (hid @ w2 + b2))
    hid = jnp.sin(freq * (hid @ w3 + b3))
    h = (hid @ w_out).reshape(n, 2, 2, HY_WIDTH)
    deltas = jnp.abs(jnp.linspace(math.log(DECAY_TARGET) / DECAY_SLOW_PCT,
                                  math.log(DECAY_TARGET) / DECAY_FAST_PCT, HY_WIDTH, dtype=F32))
    h = h * jnp.exp(-t[:, None] * deltas)[:, None, None, :]
    h_fwd = h[:, :, 0]
    h_bwd = h[1:, :, 1]
    l1 = jnp.sum(jnp.abs(h_fwd), axis=0) + jnp.sum(jnp.abs(h_bwd), axis=0)
    filt = jnp.concatenate([h_fwd, jnp.zeros((1, 2, HY_WIDTH), F32), h_bwd[::-1]], axis=0) / l1
    return jnp.fft.rfft(filt, axis=0)


def _long_conv(u, spec, d):
    n = u.shape[1]
    uf = u.astype(F32)
    y = jnp.fft.irfft(jnp.fft.rfft(uf, n=2 * n, axis=1) * spec, n=2 * n, axis=1)[:, :n]
    return (y + d.astype(F32) * uf).astype(u.dtype)


def _hyena(p, spec, d, conv_w, conv_b, on_grid):
    u = _short_conv(p, conv_w, conv_b, on_grid)
    v, x1, x2 = jnp.split(u, 3, axis=-1)
    z = x1 * _long_conv(v, spec[:, 0], d[0])
    return x2 * _long_conv(z, spec[:, 1], d[1])


def setup_inputs(seed: int = 0) -> dict:
    key = jax.random.key(seed)
    ks = iter(jax.random.split(key, 40))

    def nrm(shape, scale):
        return jax.random.normal(next(ks), shape, F32) * scale

    def gain(shape):
        return 1.0 + nrm(shape, 0.02)

    return {
        'x': nrm((BATCH, SEQ, D_MODEL), 1.0),
        'c': nrm((BATCH, D_MODEL), 1.0),
        'ctx': nrm((BATCH, CTX_LEN, D_MODEL), 1.0),
        'c_ctx': nrm((D_MODEL,), 1.0),
        'ada_w': nrm((DEPTH, D_MODEL, N_MOD * D_MODEL), D_MODEL ** -0.5),
        'ada_b': nrm((DEPTH, N_MOD * D_MODEL), 0.02),
        'norm_ffn1': gain((DEPTH, D_MODEL)),
        'ffn1_w1': nrm((DEPTH, D_MODEL, D_FF), D_MODEL ** -0.5),
        'ffn1_w3': nrm((DEPTH, D_MODEL, D_FF), D_MODEL ** -0.5),
        'ffn1_w2': nrm((DEPTH, D_FF, D_MODEL), D_FF ** -0.5),
        'norm_mix': gain((DEPTH, D_MODEL)),
        'w_in': nrm((DEPTH, D_MODEL, IN_COLS), D_MODEL ** -0.5),
        'hg_lb_logits': nrm((2, DEPTH + 1, HG_WIDTH), 0.5),
        'hg_norm': gain((DEPTH, HG_WIDTH)),
        'hy_conv_w': nrm((DEPTH, 3, 3 * HY_WIDTH), 3 ** -0.5),
        'hy_conv_b': nrm((DEPTH, 3 * HY_WIDTH), 0.02),
        'filt_w1': nrm((DEPTH, FILT_EMB, FILT_ORDER), FILT_EMB ** -0.5),
        'filt_b1': nrm((DEPTH, FILT_ORDER), 0.1),
        'filt_w2': nrm((DEPTH, FILT_ORDER, FILT_ORDER), FILT_ORDER ** -0.5),
        'filt_b2': nrm((DEPTH, FILT_ORDER), 0.1),
        'filt_w3': nrm((DEPTH, FILT_ORDER, FILT_ORDER), FILT_ORDER ** -0.5),
        'filt_b3': nrm((DEPTH, FILT_ORDER), 0.1),
        'filt_freq': 1.0 + nrm((DEPTH, FILT_ORDER), 0.1),
        'filt_w_out': nrm((DEPTH, FILT_ORDER, 4 * HY_WIDTH), FILT_ORDER ** -0.5),
        'hy_d': nrm((DEPTH, 2, HY_WIDTH), 0.1),
        'w_out': nrm((DEPTH, D_MODEL, D_MODEL), D_MODEL ** -0.5),
        'norm_ffn2': gain((DEPTH, D_MODEL)),
        'ffn2_w1': nrm((DEPTH, D_MODEL, D_FF), D_MODEL ** -0.5),
        'ffn2_w3': nrm((DEPTH, D_MODEL, D_FF), D_MODEL ** -0.5),
        'ffn2_w2': nrm((DEPTH, D_FF, D_MODEL), D_FF ** -0.5),
        'final_norm': gain((D_MODEL,)),
    }


def reference(x, c, ctx, c_ctx, ada_w, ada_b, norm_ffn1, ffn1_w1, ffn1_w3, ffn1_w2, norm_mix, w_in,
              hg_lb_logits, hg_norm, hy_conv_w, hy_conv_b, filt_w1, filt_b1, filt_w2, filt_b2, filt_w3,
              filt_b3, filt_freq, filt_w_out, hy_d, w_out, norm_ffn2, ffn2_w1, ffn2_w3, ffn2_w2, final_norm):
    bsz, lat_len, _ = x.shape
    ctx_len = ctx.shape[1]
    lower = jnp.cumsum(jax.nn.softmax(hg_lb_logits.astype(F32), axis=1), axis=1)
    zero_state = jnp.zeros((bsz, HG_HEADS, HG_DK, HG_DV), F32)
    y = ctx
    for l in range(DEPTH):
        last = l == DEPTH - 1
        mx = [m[:, None, :] for m in jnp.split(jax.nn.silu(c) @ ada_w[l] + ada_b[l], N_MOD, axis=-1)]
        mc = jnp.split(jax.nn.silu(c_ctx) @ ada_w[l] + ada_b[l], N_MOD, axis=-1)
        filt = (filt_w1[l], filt_b1[l], filt_w2[l], filt_b2[l], filt_w3[l], filt_b3[l], filt_freq[l], filt_w_out[l])
        lb = lower[:, l]

        x = x + 0.5 * mx[2] * _swiglu(_modulate(_rmsnorm(x, norm_ffn1[l]), mx[0], mx[1]),
                                      ffn1_w1[l], ffn1_w3[l], ffn1_w2[l])
        y = y + 0.5 * mc[2] * _swiglu(_modulate(_rmsnorm(y, norm_ffn1[l]), mc[0], mc[1]),
                                      ffn1_w1[l], ffn1_w3[l], ffn1_w2[l])

        hc = _modulate(_rmsnorm(y, norm_mix[l]), mc[3], mc[4])
        if last:
            pc = hc @ w_in[l][:, :COL_Q]
            kcf, gcf, kcb, gcb, vc = _hgrn_inputs(pc, lb)
            s_f = _final_state(kcf, vc, gcf)
            s_b = _final_state(_flip(kcb), _flip(vc), _flip(gcb))
        else:
            pc = hc @ w_in[l]
            kcf, gcf, kcb, gcb, vc = _hgrn_inputs(pc, lb)
            o_c, s_f, s_b = _bidir_hgrn(_query(pc), kcf, gcf, kcb, gcb, vc, zero_state, zero_state)
            mix_c = jnp.concatenate([
                _hgrn_readout(o_c, pc[..., COL_G:COL_HY], hg_norm[l]),
                _hyena(pc[..., COL_HY:], _hyena_spectrum(ctx_len, *filt), hy_d[l], hy_conv_w[l], hy_conv_b[l], False),
            ], axis=-1)
            y = y + mc[5] * (mix_c @ w_out[l])
            y = y + 0.5 * mc[8] * _swiglu(_modulate(_rmsnorm(y, norm_ffn2[l]), mc[6], mc[7]),
                                          ffn2_w1[l], ffn2_w3[l], ffn2_w2[l])

        hx = _modulate(_rmsnorm(x, norm_mix[l]), mx[3], mx[4])
        px = hx @ w_in[l]
        kxf, gxf, kxb, gxb, vx = _hgrn_inputs(px, lb)
        o_x, _, _ = _bidir_hgrn(_query(px), kxf, gxf, kxb, gxb, vx, s_f, s_b)
        mix_x = jnp.concatenate([
            _hgrn_readout(o_x, px[..., COL_G:COL_HY], hg_norm[l]),
            _hyena(px[..., COL_HY:], _hyena_spectrum(lat_len, *filt), hy_d[l], hy_conv_w[l], hy_conv_b[l], True),
        ], axis=-1)
        x = x + mx[5] * (mix_x @ w_out[l])

        x = x + 0.5 * mx[8] * _swiglu(_modulate(_rmsnorm(x, norm_ffn2[l]), mx[6], mx[7]),
                                      ffn2_w1[l], ffn2_w3[l], ffn2_w2[l])
    return _rmsnorm(x, final_norm)
```

```cpp
#include <hip/hip_runtime.h>
#include <hip/hip_cooperative_groups.h>
#include <cstdio>
#include <cstring>
namespace cg = cooperative_groups;

#ifndef ONLY_PH
#define ONLY_PH -1
#endif
#define PH(n) (p.ph_lo <= (n) && (n) < p.ph_hi && (ONLY_PH < 0 || ONLY_PH == (n)))
#define PHASE_BEGIN(n) if (p.ph_lo < (n) && (n) < p.ph_hi) grid.sync(); if (PH(n))
#ifndef HY_SCALE
#define HY_SCALE 1.0f
#endif
#ifndef HG_SCALE
#define HG_SCALE 1.0f
#endif
#ifndef SKIP_CTX
#define SKIP_CTX 0
#endif
#ifndef DEBUG_CHECK
#define DEBUG_CHECK 0
#endif
#ifndef DBG_SLOT
#define DBG_SLOT 0
#endif
#ifndef DBG_MASK
#define DBG_MASK 0x0
#endif
#ifndef SIMPLE_GEMM
#define SIMPLE_GEMM 0x0
#endif
#ifndef FN_NOGAIN
#define FN_NOGAIN 0
#endif
#ifndef ROWCHK
#define ROWCHK 0
#endif
#ifndef ROWCHK_TOL
#define ROWCHK_TOL 1e-5f
#endif
#ifndef HGCHK_TOL
#define HGCHK_TOL 1e-4f
#endif
#ifndef MULTI_LAUNCH
#define MULTI_LAUNCH 0
#endif

#define LAS __attribute__((address_space(3)))
typedef unsigned short bf16_t;
typedef short bf16x8 __attribute__((ext_vector_type(8)));
typedef float f32x4 __attribute__((ext_vector_type(4)));
typedef unsigned u32x4 __attribute__((ext_vector_type(4)));
typedef unsigned u32x2 __attribute__((ext_vector_type(2)));

constexpr int DM = 2048, NB = 8, SEQ = 4096, CTXL = 256, DFF = 5632, MODC = 18432, HGW = 1024, INC = 8192;
constexpr int ML = NB * SEQ, MC = NB * CTXL, MT = ML + MC;
constexpr int NPH = 15;
constexpr int LDS_BYTES = 131072;

constexpr size_t WS_WIN = 0;
constexpr size_t WS_WOUT = WS_WIN + (size_t)INC * DM * 2;
constexpr size_t WS_W13B = WS_WOUT + (size_t)DM * DM * 2;
constexpr size_t WS_W2B = WS_W13B + (size_t)2 * DFF * DM * 2;
constexpr size_t WS_MODP = WS_W2B + (size_t)DM * DFF * 2;
constexpr size_t WS_MOD = WS_MODP + (size_t)8 * 9 * MODC * 4;
constexpr size_t WS_HID3 = WS_MOD + (size_t)9 * MODC * 4;
constexpr size_t WS_X1C = WS_HID3 + (size_t)64 * 4096 * 4;
constexpr size_t WS_PXC = WS_X1C + (size_t)MC * DM * 4;
constexpr size_t WS_ABUF = WS_PXC + (size_t)MC * 3072 * 2;
constexpr size_t WS_C = WS_ABUF + (size_t)MT * DM * 2;
constexpr size_t WS_F = WS_C + (size_t)ML * INC * 2;
constexpr size_t WS_W13A = WS_F;
constexpr size_t WS_W2A = WS_W13A + (size_t)2 * DFF * DM * 2;
constexpr size_t WS_END = WS_F + (size_t)NB * 3072 * SEQ * 2;
static_assert((size_t)MT * DFF * 2 <= (size_t)ML * INC * 2, "H fits in region C");

struct Params {
    const float* in[31];
    float* out;
    unsigned char* ws;
    int ph_lo, ph_hi;
};
enum { I_X = 0, I_C, I_CTX, I_CCTX, I_ADAW, I_ADAB, I_NFFN1, I_F1W1, I_F1W3, I_F1W2, I_NMIX, I_WIN, I_LB, I_HGN, I_HCW, I_HCB, I_FW1, I_FB1, I_FW2, I_FB2, I_FW3, I_FB3, I_FFREQ, I_FWO, I_HYD, I_WOUT, I_NFFN2, I_F2W1, I_F2W3, I_F2W2, I_FNORM };

__device__ __forceinline__ unsigned cvt_pk_bf16(float lo, float hi) { unsigned r; asm volatile("v_cvt_pk_bf16_f32 %0, %1, %2" : "=v"(r) : "v"(lo), "v"(hi)); return r; }
__device__ __forceinline__ float bf_lo(unsigned w) { return __uint_as_float(w << 16); }
__device__ __forceinline__ float bf_hi(unsigned w) { return __uint_as_float(w & 0xffff0000u); }
__device__ __forceinline__ float bf2f(bf16_t h) { return __uint_as_float(((unsigned)h) << 16); }
__device__ __forceinline__ bf16_t f2bf(float f) { return (bf16_t)(cvt_pk_bf16(f, 0.f) & 0xffffu); }
__device__ __forceinline__ float sigmoidf_(float x) { return __builtin_amdgcn_rcpf(1.0f + __expf(-x)); }
__device__ __forceinline__ float siluf_(float x) { return x * sigmoidf_(x); }
__device__ __forceinline__ int tid_opaque() { int t = threadIdx.x; asm volatile("" : "+v"(t)); return t; }
#define HW_COS(r) __builtin_amdgcn_cosf(r)
#define HW_SIN(r) __builtin_amdgcn_sinf(r)
#define SYNC() __syncthreads()
__device__ __forceinline__ float sin_rad(float a) { float r = a * 0.15915494309189535f; r -= rintf(r); return HW_SIN(r); }
__device__ __forceinline__ float cos_rad(float a) { float r = a * 0.15915494309189535f; r -= rintf(r); return HW_COS(r); }
__device__ __forceinline__ float wave_sum(float v) {
#pragma unroll
    for (int o = 32; o > 0; o >>= 1) v += __shfl_xor(v, o);
    return v;
}

#define FPAD(i) ((i) + (((i) >> 5) << 1))
#define FFT_LDS_ELEMS 8704
__device__ __forceinline__ float2 cadd(float2 a, float2 b) { return make_float2(a.x + b.x, a.y + b.y); }
__device__ __forceinline__ float2 csub(float2 a, float2 b) { return make_float2(a.x - b.x, a.y - b.y); }
__device__ __forceinline__ float2 cmul(float2 a, float2 b) { return make_float2(a.x * b.x - a.y * b.y, a.x * b.y + a.y * b.x); }
__device__ __forceinline__ float2 cmulc(float2 a, float2 b) { return make_float2(a.x * b.x + a.y * b.y, a.y * b.x - a.x * b.y); }
__device__ __forceinline__ float2 twid(float rev) { return make_float2(HW_COS(rev), -HW_SIN(rev)); }

template <int K> struct W16 {
    static constexpr float X = (K == 0) ? 1.f : (K == 1) ? 0.92387953251f : (K == 2) ? 0.70710678119f : (K == 3) ? 0.38268343237f : (K == 4) ? 0.f : (K == 5) ? -0.38268343237f : (K == 6) ? -0.70710678119f : -0.92387953251f;
    static constexpr float Y = (K == 0) ? 0.f : (K == 1) ? -0.38268343237f : (K == 2) ? -0.70710678119f : (K == 3) ? -0.92387953251f : (K == 4) ? -1.f : (K == 5) ? -0.92387953251f : (K == 6) ? -0.70710678119f : -0.38268343237f;
};

template <int U, int ML_, bool INV> __device__ __forceinline__ void fft_bfly_group(float2 (&v)[16], float2 Tu) {
    constexpr int half = 8 >> U;
    const float2 tw = (ML_ == 0) ? Tu : cmul(Tu, make_float2(W16<(ML_ << U)>::X, W16<(ML_ << U)>::Y));
#pragma unroll
    for (int bs = 0; bs < 16; bs += 2 * half) {
        const int m = bs + ML_;
        if (!INV) { const float2 a = v[m], b = v[m + half]; v[m] = cadd(a, b); v[m + half] = cmul(csub(a, b), tw); }
        else { const float2 a = v[m], b = cmulc(v[m + half], tw); v[m] = cadd(a, b); v[m + half] = csub(a, b); }
    }
}
template <int U, bool INV> __device__ __forceinline__ void fft_stage(float2 (&v)[16], float2 Tu) {
    constexpr int half = 8 >> U;
    fft_bfly_group<U, 0, INV>(v, Tu);
    if constexpr (half > 1) fft_bfly_group<U, 1, INV>(v, Tu);
    if constexpr (half > 2) { fft_bfly_group<U, 2, INV>(v, Tu); fft_bfly_group<U, 3, INV>(v, Tu); }
    if constexpr (half > 4) { fft_bfly_group<U, 4, INV>(v, Tu); fft_bfly_group<U, 5, INV>(v, Tu); fft_bfly_group<U, 6, INV>(v, Tu); fft_bfly_group<U, 7, INV>(v, Tu); }
}
template <int P, bool INV> __device__ __forceinline__ void fft16(float2 (&v)[16], int L) {
    const float sc = 1.0f / (float)(1 << (P + 4));
    const float2 T0 = twid((float)L * sc), T1 = twid((float)(L << 1) * sc), T2 = twid((float)(L << 2) * sc), T3 = twid((float)(L << 3) * sc);
    if (!INV) { fft_stage<0, false>(v, T0); fft_stage<1, false>(v, T1); fft_stage<2, false>(v, T2); fft_stage<3, false>(v, T3); }
    else { fft_stage<3, true>(v, T3); fft_stage<2, true>(v, T2); fft_stage<1, true>(v, T1); fft_stage<0, true>(v, T0); }
}
__device__ __forceinline__ int fidxA(int tid, int m) { return tid + 512 * m; }
__device__ __forceinline__ int fidxB(int tid, int m) { return ((tid >> 5) << 9) + (m << 5) + (tid & 31); }
__device__ __forceinline__ int fidxC(int tid, int m) { return ((tid >> 1) << 5) + (m << 1) + (tid & 1); }

#define FFT_FWD_TO_PAIRS(v, buf, tid_) do { int ftid = (tid_); asm volatile("" : "+v"(ftid)); \
    fft16<9, false>(v, ftid); \
    _Pragma("unroll") for (int m = 0; m < 16; ++m) buf[FPAD(fidxA(ftid, m))] = v[m]; \
    SYNC(); \
    _Pragma("unroll") for (int m = 0; m < 16; ++m) v[m] = buf[FPAD(fidxB(ftid, m))]; \
    fft16<5, false>(v, ftid & 31); \
    _Pragma("unroll") for (int m = 0; m < 16; ++m) buf[FPAD(fidxB(ftid, m))] = v[m]; \
    SYNC(); \
    _Pragma("unroll") for (int m = 0; m < 16; ++m) v[m] = buf[FPAD(fidxC(ftid, m))]; \
    fft16<1, false>(v, ftid & 1); \
    _Pragma("unroll") for (int m = 0; m < 16; ++m) buf[FPAD(fidxC(ftid, m))] = v[m]; \
    SYNC(); \
    _Pragma("unroll") for (int q = 0; q < 8; ++q) { const int j2 = 2 * (ftid + 512 * q); const float4 pr = *(const float4*)&buf[FPAD(j2)]; \
        v[2 * q] = make_float2(pr.x + pr.z, pr.y + pr.w); v[2 * q + 1] = make_float2(pr.x - pr.z, pr.y - pr.w); } \
} while (0)

#define FFT_INV_FROM_PAIRS(v, buf, tid_) do { int ftid = (tid_); asm volatile("" : "+v"(ftid)); \
    _Pragma("unroll") for (int q = 0; q < 8; ++q) { const int j2 = 2 * (ftid + 512 * q); const float2 a = v[2 * q], b = v[2 * q + 1]; \
        *(float4*)&buf[FPAD(j2)] = make_float4(a.x + b.x, a.y + b.y, a.x - b.x, a.y - b.y); } \
    SYNC(); \
    _Pragma("unroll") for (int m = 0; m < 16; ++m) v[m] = buf[FPAD(fidxC(ftid, m))]; \
    fft16<1, true>(v, ftid & 1); \
    _Pragma("unroll") for (int m = 0; m < 16; ++m) buf[FPAD(fidxC(ftid, m))] = v[m]; \
    SYNC(); \
    _Pragma("unroll") for (int m = 0; m < 16; ++m) v[m] = buf[FPAD(fidxB(ftid, m))]; \
    fft16<5, true>(v, ftid & 31); \
    _Pragma("unroll") for (int m = 0; m < 16; ++m) buf[FPAD(fidxB(ftid, m))] = v[m]; \
    SYNC(); \
    _Pragma("unroll") for (int m = 0; m < 16; ++m) v[m] = buf[FPAD(fidxA(ftid, m))]; \
    fft16<9, true>(v, ftid); \
} while (0)

namespace pg8 {
constexpr int BM = 256, BK = 64, HALF = 128, HTB = HALF * BK * 2, STAGE_BYTES = 8 * HTB, NXCD = 8, WGM = 8;
__device__ __forceinline__ int lds_byte(int r, int c) { const int st = (r >> 4) * 2 + (c >> 5), rr = r & 15, cc = c & 31, ob = rr * 64 + cc * 2; return st * 1024 + (ob ^ (((ob >> 9) & 1) << 5)); }
__device__ __forceinline__ void stage_rc(int b, int& R, int& C) { const int st = b / 1024, sb = b % 1024, swz = sb ^ (((sb >> 9) & 1) << 5); R = (st >> 1) * 16 + swz / 64; C = (st & 1) * 32 + (swz % 64) / 2; }
__device__ __forceinline__ int perm32(int rho) { const int n = rho >> 4, i = rho & 15; return 8 * (i >> 2) + 4 * n + (i & 3); }
struct Unit { int pm, pn; };
struct Gemm { const bf16_t* A; const bf16_t* Bt; int M, N, K; };
struct StaticOrder {
    int nM, nN, nwg, G, c, extra;
    __device__ void init(int M, int N, int G_, int c_, int extra_) { nM = M / BM; nN = N / BM; nwg = nM * nN; G = G_; c = c_; extra = extra_; }
    __device__ bool next(int i, Unit& u) const {
        const long L = (long)i * G + c;
        if (L >= nwg) { const int e = (int)(L - nwg); if (e >= extra) return false; u.pm = 128 + (e & 7); u.pn = e >> 3; return true; }
        int wgid = (int)L; { const int q = nwg / NXCD, r = nwg % NXCD, xcd = wgid % NXCD, off = wgid / NXCD; wgid = (xcd < r ? xcd * (q + 1) : r * (q + 1) + (xcd - r) * q) + off; }
        const int nig = WGM * nN, gid = wgid / nig, fm = gid * WGM, gsz = (nM - fm) < WGM ? (nM - fm) : WGM;
        u.pm = fm + ((wgid % nig) % gsz); u.pn = (wgid % nig) / gsz; return true;
    }
    __device__ __forceinline__ void a_ready(const Unit&) const {}
    __device__ __forceinline__ void done(const Unit&) const {}
};

template <class Epi, class Sched>
__device__ __forceinline__ void gemm_phase(LAS unsigned char* lds, const Gemm g, const Sched& S, const Epi& E) {
    const int tid = tid_opaque(), wid = __builtin_amdgcn_readfirstlane(tid >> 6), lane = tid & 63, wr = wid >> 2, wc = wid & 3, fr = lane & 15, fq = lane >> 4;
    const int K = g.K, nt = K / BK;
    unsigned voffA[2], voffB[2];
#pragma unroll
    for (int i = 0; i < 2; ++i) { int R, C; stage_rc(tid * 16 + i * 8192, R, C); const int Rb = Epi::PERM ? ((R & ~31) + perm32(R & 31)) : R;
        voffA[i] = (unsigned)(R * K + C) * 2u; voffB[i] = (unsigned)(Rb * K + C) * 2u; }
    const size_t kstep = (size_t)(BK * 2);
    const size_t hstep = (size_t)HALF * K * 2;
    const size_t tstep = 2 * hstep;
    const unsigned ldsw = (unsigned)wid * 1024u;
    const int aoff = lds_byte(wr * 64 + fr, fq * 8), boff = lds_byte(wc * 32 + fr, fq * 8);
#define PG8_SA(b, h) (((b) * 2 + (h)) * HTB)
#define PG8_SB(b, h) ((4 + (b) * 2 + (h)) * HTB)
#define PG8_STAGE(bufoff, gbase, voff) do { _Pragma("unroll") for (int _i = 0; _i < 2; ++_i) \
        __builtin_amdgcn_global_load_lds((const unsigned*)((const char*)(gbase) + (voff)[_i]), (LAS unsigned*)(lds + (bufoff) + ldsw + _i * 8192), 16, 0, 0); } while (0)
#define PG8_LDA(dst, b, h) do { _Pragma("unroll") for (int m = 0; m < 4; ++m) _Pragma("unroll") for (int k = 0; k < 2; ++k) dst[m][k] = *(const LAS bf16x8*)(lds + PG8_SA(b, h) + aoff + m * 2048 + k * 1024); } while (0)
#define PG8_LDB(dst, b, h) do { _Pragma("unroll") for (int n = 0; n < 2; ++n) _Pragma("unroll") for (int k = 0; k < 2; ++k) dst[n][k] = *(const LAS bf16x8*)(lds + PG8_SB(b, h) + boff + n * 2048 + k * 1024); } while (0)
#define PG8_MMA(ai, bj, At, Bt) do { __builtin_amdgcn_s_setprio(1); _Pragma("unroll") for (int m = 0; m < 4; ++m) _Pragma("unroll") for (int n = 0; n < 2; ++n) _Pragma("unroll") for (int k = 0; k < 2; ++k) \
        acc[ai][bj][m][n] = __builtin_amdgcn_mfma_f32_16x16x32_bf16(Bt[n][k], At[m][k], acc[ai][bj][m][n], 0, 0, 0); __builtin_amdgcn_s_setprio(0); } while (0)
#define PG8_WAIT_V(n) asm volatile("s_waitcnt vmcnt(" #n ")" ::: "memory")
#define PG8_WAIT_L(n) asm volatile("s_waitcnt lgkmcnt(" #n ")" ::: "memory")
#define PG8_BAR __builtin_amdgcn_s_barrier()
#define PG8_SCHED __builtin_amdgcn_sched_barrier(0)
    Unit cur, nxt; int ui = 0;
    if (!S.next(0, cur)) return;
    f32x4 acc[2][2][4][2];
#pragma unroll
    for (int a = 0; a < 2; ++a)
#pragma unroll
        for (int b = 0; b < 2; ++b)
#pragma unroll
            for (int m = 0; m < 4; ++m)
#pragma unroll
                for (int n = 0; n < 2; ++n) acc[a][b][m][n] = (f32x4){0.f, 0.f, 0.f, 0.f};
    bf16x8 At[4][2], B0[2][2], B1[2][2];
    const char* cA = (const char*)g.A + (size_t)cur.pm * tstep; const char* cB = (const char*)g.Bt + (size_t)cur.pn * tstep;
    S.a_ready(cur);
    PG8_STAGE(PG8_SB(0, 0), cB, voffB); PG8_STAGE(PG8_SA(0, 0), cA, voffA); PG8_STAGE(PG8_SB(0, 1), cB + hstep, voffB); PG8_STAGE(PG8_SA(0, 1), cA + hstep, voffA);
    if (wr == 1) PG8_BAR;
    PG8_WAIT_V(4); PG8_BAR;
    PG8_STAGE(PG8_SB(1, 0), cB + kstep, voffB); PG8_STAGE(PG8_SA(1, 0), cA + kstep, voffA); PG8_STAGE(PG8_SB(1, 1), cB + hstep + kstep, voffB);
    PG8_WAIT_V(6); PG8_BAR;
    for (;;) {
        const bool has_next = S.next(ui + 1, nxt);
        const char* nA = has_next ? (const char*)g.A + (size_t)nxt.pm * tstep : cA; const char* nB = has_next ? (const char*)g.Bt + (size_t)nxt.pn * tstep : cB;
        for (int t = 0; t < nt; t += 2) {
            const bool last = (t == nt - 2);
            const char* a1 = cA + (size_t)(t + 1) * kstep;
            const char* a2 = last ? nA : cA + (size_t)(t + 2) * kstep; const char* b2 = last ? nB : cB + (size_t)(t + 2) * kstep;
            const char* a3 = a2 + kstep; const char* b3 = b2 + kstep;
            if (last && has_next) S.a_ready(nxt);
            PG8_LDB(B0, 0, 0); PG8_SCHED; PG8_LDA(At, 0, 0); PG8_STAGE(PG8_SA(1, 1), a1 + hstep, voffA);
            PG8_WAIT_L(8); PG8_BAR; PG8_WAIT_L(0); PG8_MMA(0, 0, At, B0); PG8_BAR; PG8_SCHED;
            PG8_LDB(B1, 0, 1); PG8_STAGE(PG8_SB(0, 0), b2, voffB);
            PG8_BAR; PG8_WAIT_L(0); PG8_MMA(0, 1, At, B1); PG8_BAR;
            PG8_LDA(At, 0, 1); PG8_STAGE(PG8_SA(0, 0), a2, voffA);
            PG8_BAR; PG8_WAIT_L(0); PG8_MMA(1, 0, At, B0); PG8_BAR; PG8_SCHED;
            PG8_STAGE(PG8_SB(0, 1), b2 + hstep, voffB);
            PG8_WAIT_V(6); PG8_BAR; PG8_MMA(1, 1, At, B1); PG8_BAR;
            PG8_LDB(B0, 1, 0); PG8_SCHED; PG8_LDA(At, 1, 0); PG8_STAGE(PG8_SA(0, 1), a2 + hstep, voffA);
            PG8_WAIT_L(8); PG8_BAR; PG8_WAIT_L(0); PG8_MMA(0, 0, At, B0); PG8_BAR; PG8_SCHED;
            PG8_LDB(B1, 1, 1); PG8_STAGE(PG8_SB(1, 0), b3, voffB);
            PG8_BAR; PG8_WAIT_L(0); PG8_MMA(0, 1, At, B1); PG8_BAR;
            PG8_LDA(At, 1, 1); PG8_STAGE(PG8_SA(1, 0), a3, voffA);
            PG8_BAR; PG8_WAIT_L(0); PG8_MMA(1, 0, At, B0); PG8_BAR; PG8_SCHED;
            PG8_STAGE(PG8_SB(1, 1), b3 + hstep, voffB);
            PG8_WAIT_V(6); PG8_BAR; PG8_MMA(1, 1, At, B1); PG8_BAR;
        }
        E(acc, cur, wr, wc, fr, fq); S.done(cur);
        if (!has_next) break;
#pragma unroll
        for (int a = 0; a < 2; ++a)
#pragma unroll
            for (int b = 0; b < 2; ++b)
#pragma unroll
                for (int m = 0; m < 4; ++m)
#pragma unroll
                    for (int n = 0; n < 2; ++n) acc[a][b][m][n] = (f32x4){0.f, 0.f, 0.f, 0.f};
        cur = nxt; cA = nA; cB = nB; ++ui;
    }
    PG8_WAIT_V(0);
    if (wr == 0) PG8_BAR;
    PG8_BAR;
#undef PG8_SA
#undef PG8_SB
#undef PG8_STAGE
#undef PG8_LDA
#undef PG8_LDB
#undef PG8_MMA
#undef PG8_WAIT_V
#undef PG8_WAIT_L
#undef PG8_BAR
#undef PG8_SCHED
}
}

struct EpiSwiGLU {
    static constexpr bool PERM = true;
    bf16_t* H;
    __device__ __forceinline__ void operator()(const f32x4 (&acc)[2][2][4][2], const pg8::Unit& u, int wr, int wc, int fr, int fq) const {
        const int row0 = u.pm * 256 + wr * 64 + fr, col0 = u.pn * 128 + wc * 32 + 8 * fq;
#pragma unroll
        for (int ai = 0; ai < 2; ++ai)
#pragma unroll
            for (int m = 0; m < 4; ++m) {
                bf16_t* rowp = H + (size_t)(row0 + ai * 128 + m * 16) * DFF + col0;
                float h[8];
#pragma unroll
                for (int n = 0; n < 2; ++n)
#pragma unroll
                    for (int j = 0; j < 4; ++j) { const float gt = acc[ai][0][m][n][j], up = acc[ai][1][m][n][j]; h[n * 4 + j] = siluf_(gt) * up; }
                u32x4 w; w.x = cvt_pk_bf16(h[0], h[1]); w.y = cvt_pk_bf16(h[2], h[3]); w.z = cvt_pk_bf16(h[4], h[5]); w.w = cvt_pk_bf16(h[6], h[7]);
                *(u32x4*)rowp = w;
            }
    }
};
struct EpiBf16 {
    static constexpr bool PERM = true;
    bf16_t* O; int ldl; bf16_t* OC; int ldc;
    __device__ __forceinline__ void operator()(const f32x4 (&acc)[2][2][4][2], const pg8::Unit& u, int wr, int wc, int fr, int fq) const {
        const bool isc = u.pm >= 128;
        bf16_t* base = isc ? OC : O; const int ld = isc ? ldc : ldl;
        const int row0 = (isc ? (u.pm - 128) : u.pm) * 256 + wr * 64 + fr, col0 = u.pn * 256 + wc * 32 + 8 * fq;
#pragma unroll
        for (int ai = 0; ai < 2; ++ai)
#pragma unroll
            for (int m = 0; m < 4; ++m) {
                bf16_t* rowp = base + (size_t)(row0 + ai * 128 + m * 16) * ld + col0;
#pragma unroll
                for (int bj = 0; bj < 2; ++bj) {
                    const f32x4 v0 = acc[ai][bj][m][0], v1 = acc[ai][bj][m][1];
                    u32x4 w; w.x = cvt_pk_bf16(v0[0], v0[1]); w.y = cvt_pk_bf16(v0[2], v0[3]); w.z = cvt_pk_bf16(v1[0], v1[1]); w.w = cvt_pk_bf16(v1[2], v1[3]);
                    *(u32x4*)(rowp + bj * 128) = w;
                }
            }
    }
};
struct EpiRes {
    static constexpr bool PERM = false;
    const float* srcL; float* dstL; const float* srcC; float* dstC; const float* gate; float coef;
    __device__ __forceinline__ void operator()(const f32x4 (&acc)[2][2][4][2], const pg8::Unit& u, int wr, int wc, int fr, int fq) const {
        const bool isc = u.pm >= 128;
        const float* src = isc ? srcC : srcL; float* dst = isc ? dstC : dstL;
        const int modrow = isc ? 8 : (u.pm >> 4);
        const int row0 = (isc ? (u.pm - 128) : u.pm) * 256 + wr * 64 + fr, col0 = u.pn * 256 + wc * 32 + 4 * fq;
        const float* gp = gate + (size_t)modrow * MODC + col0;
        f32x4 gv[2][2];
#pragma unroll
        for (int bj = 0; bj < 2; ++bj)
#pragma unroll
            for (int n = 0; n < 2; ++n) gv[bj][n] = *(const f32x4*)(gp + bj * 128 + n * 16) * coef;
#pragma unroll
        for (int ai = 0; ai < 2; ++ai)
#pragma unroll
            for (int m = 0; m < 4; ++m) {
                const size_t ro = (size_t)(row0 + ai * 128 + m * 16) * DM + col0;
#pragma unroll
                for (int bj = 0; bj < 2; ++bj)
#pragma unroll
                    for (int n = 0; n < 2; ++n) {
                        const f32x4 s = *(const f32x4*)(src + ro + bj * 128 + n * 16);
                        *(f32x4*)(dst + ro + bj * 128 + n * 16) = s + gv[bj][n] * acc[ai][bj][m][n];
                    }
            }
    }
};


template <class Epi, class Sched>
__device__ __forceinline__ void gemm_simple(const pg8::Gemm g, const Sched& S, const Epi& E) {
    const int tid = tid_opaque(), wid = tid >> 6, lane = tid & 63, wr = wid >> 2, wc = wid & 3, fr = lane & 15, fq = lane >> 4;
    const int K = g.K;
    pg8::Unit u;
    for (int i = 0; S.next(i, u); ++i) {
        f32x4 acc[2][2][4][2];
#pragma unroll
        for (int a = 0; a < 2; ++a)
#pragma unroll
            for (int b = 0; b < 2; ++b)
#pragma unroll
                for (int m = 0; m < 4; ++m)
#pragma unroll
                    for (int n = 0; n < 2; ++n) acc[a][b][m][n] = (f32x4){0.f, 0.f, 0.f, 0.f};
        const bf16_t* Ab = g.A + (size_t)(u.pm * 256 + wr * 64 + fr) * K + fq * 8;
        const bf16_t* Bb0 = g.Bt + (size_t)(u.pn * 256 + wc * 32 + (Epi::PERM ? pg8::perm32(fr) : fr)) * K + fq * 8;
        const bf16_t* Bb1 = g.Bt + (size_t)(u.pn * 256 + wc * 32 + (Epi::PERM ? pg8::perm32(16 + fr) : 16 + fr)) * K + fq * 8;
#pragma unroll 1
        for (int k0 = 0; k0 < K; k0 += 32) {
            bf16x8 a[2][4], b[2][2];
#pragma unroll
            for (int ai = 0; ai < 2; ++ai)
#pragma unroll
                for (int m = 0; m < 4; ++m) a[ai][m] = *(const bf16x8*)(Ab + (size_t)(ai * 128 + m * 16) * K + k0);
#pragma unroll
            for (int bj = 0; bj < 2; ++bj) { b[bj][0] = *(const bf16x8*)(Bb0 + (size_t)(bj * 128) * K + k0); b[bj][1] = *(const bf16x8*)(Bb1 + (size_t)(bj * 128) * K + k0); }
#pragma unroll
            for (int ai = 0; ai < 2; ++ai)
#pragma unroll
                for (int bj = 0; bj < 2; ++bj)
#pragma unroll
                    for (int m = 0; m < 4; ++m)
#pragma unroll
                        for (int n = 0; n < 2; ++n) acc[ai][bj][m][n] = __builtin_amdgcn_mfma_f32_16x16x32_bf16(b[bj][n], a[ai][m], acc[ai][bj][m][n], 0, 0, 0);
        }
        E(acc, u, wr, wc, fr, fq);
    }
}
#define GEMM_RUN(phn, g, S, E) do { if (SIMPLE_GEMM & (1 << (phn))) gemm_simple(g, S, E); else pg8::gemm_phase(lds, g, S, E); } while (0)

__device__ __forceinline__ void tr_tile(const float* __restrict__ src, int N, bf16_t* __restrict__ dst, int K, int k0, int n0, int rs, int off, float* tile) {
    const int tid = tid_opaque();
    const int c4 = (tid & 15) * 4;
#pragma unroll
    for (int pss = 0; pss < 2; ++pss) {
        const int r = (tid >> 4) + 32 * pss;
        const float4 x = *(const float4*)(src + (size_t)(k0 + r) * N + n0 + c4);
        float* t = tile + r * 65 + c4; t[0] = x.x; t[1] = x.y; t[2] = x.z; t[3] = x.w;
    }
    __syncthreads();
    const int n = tid >> 3, kq = tid & 7;
    float e[8];
#pragma unroll
    for (int j = 0; j < 8; ++j) e[j] = tile[(kq * 8 + j) * 65 + n];
    const int nn = n0 + n, row = (nn >> 7) * rs + off + (nn & 127);
    u32x4 w; w.x = cvt_pk_bf16(e[0], e[1]); w.y = cvt_pk_bf16(e[2], e[3]); w.z = cvt_pk_bf16(e[4], e[5]); w.w = cvt_pk_bf16(e[6], e[7]);
    *(u32x4*)(dst + (size_t)row * K + k0 + kq * 8) = w;
    __syncthreads();
}

__device__ __forceinline__ void phase_prep(const Params& p, unsigned char* shm) {
    const int tid = tid_opaque(), G = gridDim.x, bid = blockIdx.x;
    float* tile = (float*)shm;
    for (int t = bid; t < 22016; t += G) {
        int job, lt = t;
        if (lt < 2816) job = 0; else if ((lt -= 2816) < 2816) job = 1; else if ((lt -= 2816) < 2816) job = 2; else if ((lt -= 2816) < 4096) job = 3;
        else if ((lt -= 4096) < 1024) job = 4; else if ((lt -= 1024) < 2816) job = 5; else if ((lt -= 2816) < 2816) job = 6; else { lt -= 2816; job = 7; }
        const float* src; bf16_t* dst; int K, N, rs = 128, off = 0;
        switch (job) {
            case 0: src = p.in[I_F1W1]; dst = (bf16_t*)(p.ws + WS_W13A); K = DM; N = DFF; rs = 256; break;
            case 1: src = p.in[I_F1W3]; dst = (bf16_t*)(p.ws + WS_W13A); K = DM; N = DFF; rs = 256; off = 128; break;
            case 2: src = p.in[I_F1W2]; dst = (bf16_t*)(p.ws + WS_W2A); K = DFF; N = DM; break;
            case 3: src = p.in[I_WIN]; dst = (bf16_t*)(p.ws + WS_WIN); K = DM; N = INC; break;
            case 4: src = p.in[I_WOUT]; dst = (bf16_t*)(p.ws + WS_WOUT); K = DM; N = DM; break;
            case 5: src = p.in[I_F2W1]; dst = (bf16_t*)(p.ws + WS_W13B); K = DM; N = DFF; rs = 256; break;
            case 6: src = p.in[I_F2W3]; dst = (bf16_t*)(p.ws + WS_W13B); K = DM; N = DFF; rs = 256; off = 128; break;
            default: src = p.in[I_F2W2]; dst = (bf16_t*)(p.ws + WS_W2B); K = DFF; N = DM; break;
        }
        const int nkt = K >> 6;
        const int kt = lt % nkt, ntl = lt / nkt;
        tr_tile(src, N, dst, K, kt * 64, ntl * 64, rs, off, tile);
    }
    {
        float* s = (float*)shm;
        float* mod = (float*)(p.ws + WS_MOD);
        for (int it = bid; it < 36; it += G) {
            __syncthreads();
            for (int i = tid; i < 9 * DM; i += 512) { const int j = i >> 11, k = i & 2047; const float cv = (j < 8) ? p.in[I_C][j * DM + k] : p.in[I_CCTX][k]; s[i] = siluf_(cv); }
            __syncthreads();
            const int col = it * 512 + tid;
            const float* wp = p.in[I_ADAW] + col;
            float acc[9];
#pragma unroll
            for (int j = 0; j < 9; ++j) acc[j] = p.in[I_ADAB][col];
#pragma unroll 2
            for (int k = 0; k < DM; k += 4) {
                const float w0 = wp[(size_t)(k + 0) * MODC], w1 = wp[(size_t)(k + 1) * MODC], w2 = wp[(size_t)(k + 2) * MODC], w3 = wp[(size_t)(k + 3) * MODC];
#pragma unroll
                for (int j = 0; j < 9; ++j) { const float4 sv = *(const float4*)&s[j * DM + k]; acc[j] += sv.x * w0 + sv.y * w1 + sv.z * w2 + sv.w * w3; }
            }
#pragma unroll
            for (int j = 0; j < 9; ++j) mod[(size_t)j * MODC + col] = acc[j];
        }
        __syncthreads();
    }
    {
        float* z = (float*)shm;
        float* h1 = z + 8 * 36;
        float* h2 = h1 + 8 * 64;
        float* hid3T = (float*)(p.ws + WS_HID3);
        const int lg = tid >> 6, unit = tid & 63;
        const float fr = p.in[I_FFREQ][unit];
        for (int it = bid; it < 512; it += G) {
            const int lag = it * 8 + lg;
            __syncthreads();
            if (unit < 33) {
                float val;
                if (unit == 0) val = (float)lag / 4095.0f;
                else {
                    const int i = (unit - 1) & 15;
                    const float fb = 1e-4f + (float)i * ((15.0f - 1e-4f) / 15.0f);
                    const float ang = (0.0015339807878856412f * (float)lag) * fb;
                    val = (unit <= 16) ? cos_rad(ang) : -sin_rad(ang);
                }
                z[lg * 36 + unit] = val;
            }
            __syncthreads();
            float a = p.in[I_FB1][unit];
#pragma unroll 3
            for (int i = 0; i < 33; ++i) a += z[lg * 36 + i] * p.in[I_FW1][i * 64 + unit];
            h1[lg * 64 + unit] = sin_rad(fr * a);
            __syncthreads();
            a = p.in[I_FB2][unit];
#pragma unroll 8
            for (int i = 0; i < 64; ++i) a += h1[lg * 64 + i] * p.in[I_FW2][i * 64 + unit];
            h2[lg * 64 + unit] = sin_rad(fr * a);
            __syncthreads();
            a = p.in[I_FB3][unit];
#pragma unroll 8
            for (int i = 0; i < 64; ++i) a += h2[lg * 64 + i] * p.in[I_FW3][i * 64 + unit];
            hid3T[unit * 4096 + lag] = sin_rad(fr * a);
        }
        __syncthreads();
    }
}

__device__ __forceinline__ void phase_modreduce(const Params& p) {
    const float* modp = (const float*)(p.ws + WS_MODP);
    float* mod = (float*)(p.ws + WS_MOD);
    for (int i = blockIdx.x * 512 + tid_opaque(); i < 9 * MODC; i += gridDim.x * 512) {
        const int col = i % MODC;
        float a = p.in[I_ADAB][col];
#pragma unroll
        for (int ks = 0; ks < 8; ++ks) a += modp[(size_t)ks * 9 * MODC + i];
        mod[i] = a;
    }
}

__device__ __forceinline__ void phase_norm(const Params& p, const float* srcL, const float* srcC, int nrows, const float* gw, int sidx) {
    const int tid = tid_opaque(); const int lane = tid & 63, gwv = blockIdx.x * 8 + (tid >> 6), nw = gridDim.x * 8;
    const float* mod = (const float*)(p.ws + WS_MOD);
    bf16_t* A = (bf16_t*)(p.ws + WS_ABUF);
    for (int r = gwv; r < nrows; r += nw) {
        const float* src = (r < ML) ? srcL + (size_t)r * DM : srcC + (size_t)(r - ML) * DM;
        const int mrow = (r < ML) ? (r >> 12) : 8;
        const float* sh = mod + (size_t)mrow * MODC + sidx * DM; const float* sc = sh + DM;
        float4 xv[8]; float ss = 0.f;
#pragma unroll
        for (int i = 0; i < 8; ++i) { xv[i] = *(const float4*)(src + (i * 64 + lane) * 4); ss += xv[i].x * xv[i].x + xv[i].y * xv[i].y + xv[i].z * xv[i].z + xv[i].w * xv[i].w; }
        ss = wave_sum(ss);
        const float inv = rsqrtf(ss * (1.0f / DM) + 1e-6f);
#pragma unroll
        for (int i = 0; i < 8; ++i) {
            const int c = (i * 64 + lane) * 4;
            const float4 g = *(const float4*)(gw + c), s1 = *(const float4*)(sc + c), s0 = *(const float4*)(sh + c);
            const float o0 = xv[i].x * inv * g.x * (1.f + s1.x) + s0.x, o1 = xv[i].y * inv * g.y * (1.f + s1.y) + s0.y;
            const float o2 = xv[i].z * inv * g.z * (1.f + s1.z) + s0.z, o3 = xv[i].w * inv * g.w * (1.f + s1.w) + s0.w;
            u32x2 w; w.x = cvt_pk_bf16(o0, o1); w.y = cvt_pk_bf16(o2, o3);
            *(u32x2*)(A + (size_t)r * DM + c) = w;
        }
    }
}

__device__ __forceinline__ void phase_final_norm(const Params& p) {
    const int tid = tid_opaque(); const int lane = tid & 63, gwv = blockIdx.x * 8 + (tid >> 6), nw = gridDim.x * 8;
    const float* gw = p.in[I_FNORM];
    for (int r = gwv; r < ML; r += nw) {
        float* row = p.out + (size_t)r * DM;
        float4 xv[8]; float ss = 0.f;
#pragma unroll
        for (int i = 0; i < 8; ++i) { xv[i] = *(const float4*)(row + (i * 64 + lane) * 4); ss += xv[i].x * xv[i].x + xv[i].y * xv[i].y + xv[i].z * xv[i].z + xv[i].w * xv[i].w; }
        ss = wave_sum(ss);
        const float inv = rsqrtf(ss * (1.0f / DM) + 1e-6f);
#pragma unroll
        for (int i = 0; i < 8; ++i) {
            const int c = (i * 64 + lane) * 4;
            const float4 g = *(const float4*)(gw + c);
            *(float4*)(row + c) = FN_NOGAIN ? make_float4(xv[i].x * inv, xv[i].y * inv, xv[i].z * inv, xv[i].w * inv) : make_float4(xv[i].x * inv * g.x, xv[i].y * inv * g.y, xv[i].z * inv * g.z, xv[i].w * inv * g.w);
        }
    }
}

__device__ __forceinline__ void phase_shortconv(const Params& p, unsigned char* shm) {
    const int tid = tid_opaque();
    float* tile = (float*)shm;
    const bf16_t* PX = (const bf16_t*)(p.ws + WS_C);
    bf16_t* UT = (bf16_t*)(p.ws + WS_F);
    for (int t = blockIdx.x; t < NB * 64 * 48; t += gridDim.x) {
        const int cgp = t % 48, gr = (t / 48) & 63, b = t / (48 * 64);
        {
            const int tt = tid >> 3, c8 = (tid & 7) * 8;
            const u32x4 w = *(const u32x4*)(PX + (size_t)(b * SEQ + gr * 64 + tt) * INC + 5120 + cgp * 64 + c8);
            float* tp = tile + tt * 65 + c8;
            tp[0] = bf_lo(w.x); tp[1] = bf_hi(w.x); tp[2] = bf_lo(w.y); tp[3] = bf_hi(w.y); tp[4] = bf_lo(w.z); tp[5] = bf_hi(w.z); tp[6] = bf_lo(w.w); tp[7] = bf_hi(w.w);
        }
        __syncthreads();
        {
            const int cc = tid >> 3, t8 = (tid & 7) * 8, ch = cgp * 64 + cc;
            const float w0 = p.in[I_HCW][ch], w1 = p.in[I_HCW][3072 + ch], w2 = p.in[I_HCW][6144 + ch], bb = p.in[I_HCB][ch];
            float u[10];
#pragma unroll
            for (int j = 0; j < 10; ++j) { const int tt = t8 - 1 + j; u[j] = (tt >= 0 && tt < 64) ? tile[tt * 65 + cc] : 0.f; }
            float o[8];
#pragma unroll
            for (int j = 0; j < 8; ++j) o[j] = u[j] * w0 + u[j + 1] * w1 + u[j + 2] * w2 + bb;
            u32x4 w; w.x = cvt_pk_bf16(o[0], o[1]); w.y = cvt_pk_bf16(o[2], o[3]); w.z = cvt_pk_bf16(o[4], o[5]); w.w = cvt_pk_bf16(o[6], o[7]);
            *(u32x4*)(UT + ((size_t)(b * 3072 + ch)) * SEQ + gr * 64 + t8) = w;
        }
        __syncthreads();
    }
}

__device__ __forceinline__ int hg_row(int c, int s, int dir, int b) {
    if (c < 8) { const int q = c * 32 + s; return b * CTXL + (dir ? (CTXL - 1 - q) : q); }
    const int q = (c - 8) * 32 + s; return b * SEQ + (dir ? (SEQ - 1 - q) : q);
}
__device__ __forceinline__ void hgrn_item(const Params& p, int item, unsigned char* shm) {
    const int tid = tid_opaque(), w = tid >> 6, lane = tid & 63;
    const int dir = item & 1, vh = (item >> 1) & 1, h = (item >> 2) & 7, b = item >> 5;
    float* F = (float*)shm;
    float* Q = F + 32 * 128;
    float* V = Q + 32 * 128;
    float* OP = V + 32 * 64;
    const bf16_t* PX = (const bf16_t*)(p.ws + WS_C);
    const bf16_t* PXC = (const bf16_t*)(p.ws + WS_PXC);
    bf16_t* MIX = (bf16_t*)(p.ws + WS_ABUF);
    const int ls = tid >> 4, lk = (tid & 15) * 8;
    const int vs = (tid >> 3) & 31, v8 = (tid & 7) * 8;
    float lbv[8];
#pragma unroll
    for (int i = 0; i < 8; ++i) { const int j = h * 128 + lk + i; lbv[i] = sigmoidf_(p.in[I_LB][dir * 2048 + j] - p.in[I_LB][dir * 2048 + 1024 + j]); }
    float S[16];
#pragma unroll
    for (int i = 0; i < 16; ++i) S[i] = 0.f;
    u32x4 rf, rq, rv;
    rq = (u32x4){0u, 0u, 0u, 0u}; rv = rq;
#if SKIP_CTX
    {
        const size_t ro = (size_t)hg_row(8, ls, dir, b) * INC;
        rf = *(const u32x4*)(PX + ro + dir * 1024 + h * 128 + lk);
        rq = *(const u32x4*)(PX + ro + 3072 + h * 128 + lk);
        if (tid < 256) rv = *(const u32x4*)(PX + (size_t)hg_row(8, vs, dir, b) * INC + 2048 + h * 128 + vh * 64 + v8);
    }
    for (int c = 8; c < 136; ++c) {
#else
    {
        const size_t ro = (size_t)hg_row(0, ls, dir, b) * 3072;
        rf = *(const u32x4*)(PXC + ro + dir * 1024 + h * 128 + lk);
        if (tid < 256) rv = *(const u32x4*)(PXC + (size_t)hg_row(0, vs, dir, b) * 3072 + 2048 + h * 128 + vh * 64 + v8);
    }
    for (int c = 0; c < 136; ++c) {
#endif
        const bool lat = c >= 8;
        __syncthreads();
        {
            float* fp = F + ls * 128 + lk;
            const float a0 = bf_lo(rf.x), a1 = bf_hi(rf.x), a2 = bf_lo(rf.y), a3 = bf_hi(rf.y), a4 = bf_lo(rf.z), a5 = bf_hi(rf.z), a6 = bf_lo(rf.w), a7 = bf_hi(rf.w);
            *(float4*)fp = make_float4(lbv[0] + (1.f - lbv[0]) * sigmoidf_(a0), lbv[1] + (1.f - lbv[1]) * sigmoidf_(a1), lbv[2] + (1.f - lbv[2]) * sigmoidf_(a2), lbv[3] + (1.f - lbv[3]) * sigmoidf_(a3));
            *(float4*)(fp + 4) = make_float4(lbv[4] + (1.f - lbv[4]) * sigmoidf_(a4), lbv[5] + (1.f - lbv[5]) * sigmoidf_(a5), lbv[6] + (1.f - lbv[6]) * sigmoidf_(a6), lbv[7] + (1.f - lbv[7]) * sigmoidf_(a7));
            if (lat) {
                const float qs = 0.08838834764831845f;
                float* qp = Q + ls * 128 + lk;
                *(float4*)qp = make_float4(bf_lo(rq.x) * qs, bf_hi(rq.x) * qs, bf_lo(rq.y) * qs, bf_hi(rq.y) * qs);
                *(float4*)(qp + 4) = make_float4(bf_lo(rq.z) * qs, bf_hi(rq.z) * qs, bf_lo(rq.w) * qs, bf_hi(rq.w) * qs);
            }
            if (tid < 256) {
                float* vp = V + vs * 64 + v8;
                *(float4*)vp = make_float4(bf_lo(rv.x), bf_hi(rv.x), bf_lo(rv.y), bf_hi(rv.y));
                *(float4*)(vp + 4) = make_float4(bf_lo(rv.z), bf_hi(rv.z), bf_lo(rv.w), bf_hi(rv.w));
            }
        }
        __syncthreads();
        if (c + 1 < 136) {
            const int cn = c + 1;
            if (cn < 8) {
                rf = *(const u32x4*)(PXC + (size_t)hg_row(cn, ls, dir, b) * 3072 + dir * 1024 + h * 128 + lk);
                if (tid < 256) rv = *(const u32x4*)(PXC + (size_t)hg_row(cn, vs, dir, b) * 3072 + 2048 + h * 128 + vh * 64 + v8);
            } else {
                const size_t ro = (size_t)hg_row(cn, ls, dir, b) * INC;
                rf = *(const u32x4*)(PX + ro + dir * 1024 + h * 128 + lk);
                rq = *(const u32x4*)(PX + ro + 3072 + h * 128 + lk);
                if (tid < 256) rv = *(const u32x4*)(PX + (size_t)hg_row(cn, vs, dir, b) * INC + 2048 + h * 128 + vh * 64 + v8);
            }
        }
        if (!lat) {
            for (int s = 0; s < 32; ++s) {
                const float vv = V[s * 64 + lane];
#pragma unroll
                for (int k4 = 0; k4 < 4; ++k4) {
                    const float4 f4 = *(const float4*)&F[s * 128 + w * 16 + k4 * 4];
                    S[k4 * 4 + 0] = f4.x * S[k4 * 4 + 0] + (vv - f4.x * vv);
                    S[k4 * 4 + 1] = f4.y * S[k4 * 4 + 1] + (vv - f4.y * vv);
                    S[k4 * 4 + 2] = f4.z * S[k4 * 4 + 2] + (vv - f4.z * vv);
                    S[k4 * 4 + 3] = f4.w * S[k4 * 4 + 3] + (vv - f4.w * vv);
                }
            }
        } else {
            for (int s = 0; s < 32; ++s) {
                const float vv = V[s * 64 + lane];
                float o = 0.f;
#pragma unroll
                for (int k4 = 0; k4 < 4; ++k4) {
                    const float4 f4 = *(const float4*)&F[s * 128 + w * 16 + k4 * 4];
                    const float4 q4 = *(const float4*)&Q[s * 128 + w * 16 + k4 * 4];
                    S[k4 * 4 + 0] = f4.x * S[k4 * 4 + 0] + (vv - f4.x * vv); o += S[k4 * 4 + 0] * q4.x;
                    S[k4 * 4 + 1] = f4.y * S[k4 * 4 + 1] + (vv - f4.y * vv); o += S[k4 * 4 + 1] * q4.y;
                    S[k4 * 4 + 2] = f4.z * S[k4 * 4 + 2] + (vv - f4.z * vv); o += S[k4 * 4 + 2] * q4.z;
                    S[k4 * 4 + 3] = f4.w * S[k4 * 4 + 3] + (vv - f4.w * vv); o += S[k4 * 4 + 3] * q4.w;
                }
                OP[(w * 32 + s) * 64 + lane] = o;
            }
            __syncthreads();
            {
                const int s = tid >> 4, v4 = (tid & 15) * 4;
                float4 a = *(const float4*)&OP[s * 64 + v4];
#pragma unroll
                for (int ww = 1; ww < 8; ++ww) { const float4 t = *(const float4*)&OP[(ww * 32 + s) * 64 + v4]; a.x += t.x; a.y += t.y; a.z += t.z; a.w += t.w; }
                u32x2 pk; pk.x = cvt_pk_bf16(a.x, a.y); pk.y = cvt_pk_bf16(a.z, a.w);
                *(u32x2*)(MIX + (size_t)hg_row(c, s, dir, b) * DM + dir * 1024 + h * 128 + vh * 64 + v4) = pk;
            }
        }
    }
    __syncthreads();
}

__device__ __forceinline__ void hyena_item(const Params& p, int c, unsigned char* shm) {
    int tid = tid_opaque();
    float2* buf = (float2*)shm;
    float* wsm = (float*)(shm + FFT_LDS_ELEMS * 8);
    float* red = wsm + 256;
    bf16_t* UT = (bf16_t*)(p.ws + WS_F);
    const float* hid3T = (const float*)(p.ws + WS_HID3);
    __syncthreads();
    if (tid < 256) { const int j = tid >> 2, q = tid & 3; wsm[tid] = p.in[I_FWO][j * 4096 + q * 1024 + c]; }
    __syncthreads();
    const float dlo = -3.0701134573253945f, dhi = -15.350567286626972f;
    const float delta = fabsf(dlo + (float)c * ((dhi - dlo) / 1023.0f));
    float g0[16], g1[16];
    float l0 = 0.f, l1 = 0.f;
    {
        const float* hp[16];
#pragma unroll
        for (int m = 0; m < 16; ++m) {
            const int idx = tid + 512 * m;
            int lag = (m < 8) ? idx : (8192 - idx);
            lag = (lag < 4096) ? lag : 4095;
            hp[m] = hid3T + lag;
            g0[m] = 0.f; g1[m] = 0.f;
        }
#pragma unroll 2
        for (int j = 0; j < 64; ++j) {
            const float4 wv = *(const float4*)&wsm[j * 4];
#pragma unroll
            for (int m = 0; m < 16; ++m) {
                const float hv = hp[m][j * 4096];
                g0[m] += hv * ((m < 8) ? wv.x : wv.y);
                g1[m] += hv * ((m < 8) ? wv.z : wv.w);
            }
        }
#pragma unroll
        for (int m = 0; m < 16; ++m) {
            const int idx = tid + 512 * m;
            const int lag = (m < 8) ? idx : (8192 - idx);
            const float win = (lag < 4096) ? __expf(-((float)lag * (1.0f / 4095.0f)) * delta) : 0.f;
            g0[m] *= win; g1[m] *= win;
            l0 += fabsf(g0[m]); l1 += fabsf(g1[m]);
        }
    }
    l0 = wave_sum(l0); l1 = wave_sum(l1);
    if ((tid & 63) == 0) { red[(tid >> 6) * 2] = l0; red[(tid >> 6) * 2 + 1] = l1; }
    __syncthreads();
    l0 = 0.f; l1 = 0.f;
#pragma unroll
    for (int i = 0; i < 8; ++i) { l0 += red[i * 2]; l1 += red[i * 2 + 1]; }
    const float d0 = p.in[I_HYD][c], d1 = p.in[I_HYD][1024 + c];
#pragma unroll 1
    for (int f = 0; f < 2; ++f) {
        float2 v[16], H[16];
        const float sc = 1.0f / ((f ? l1 : l0) * 8192.0f);
#pragma unroll
        for (int m = 0; m < 16; ++m) v[m] = make_float2((f ? g1[m] : g0[m]) * sc, 0.f);
        FFT_FWD_TO_PAIRS(v, buf, tid);
#pragma unroll
        for (int m = 0; m < 16; ++m) H[m] = v[m];
        __syncthreads();
        const float dd = f ? d1 : d0;
#pragma unroll 1
        for (int pr = 0; pr < 4; ++pr) {
            asm volatile("" : "+v"(tid));
            const int b0 = 2 * pr, b1 = b0 + 1;
            bf16_t* s0 = UT + ((size_t)(b0 * 3072 + (f ? 1024 : 0) + c)) * SEQ;
            bf16_t* s1 = UT + ((size_t)(b1 * 3072 + (f ? 1024 : 0) + c)) * SEQ;
            float in0[8], in1[8];
#pragma unroll
            for (int m = 0; m < 8; ++m) { in0[m] = bf2f(s0[tid + 512 * m]); in1[m] = bf2f(s1[tid + 512 * m]); v[m] = make_float2(in0[m], in1[m]); v[m + 8] = make_float2(0.f, 0.f); }
            FFT_FWD_TO_PAIRS(v, buf, tid);
#pragma unroll
            for (int m = 0; m < 16; ++m) v[m] = cmul(v[m], H[m]);
            FFT_INV_FROM_PAIRS(v, buf, tid);
            bf16_t* x0 = UT + ((size_t)(b0 * 3072 + (f ? 2048 : 1024) + c)) * SEQ;
            bf16_t* x1 = UT + ((size_t)(b1 * 3072 + (f ? 2048 : 1024) + c)) * SEQ;
            bf16_t* o0 = f ? UT + ((size_t)(b0 * 3072 + c)) * SEQ : x0;
            bf16_t* o1 = f ? UT + ((size_t)(b1 * 3072 + c)) * SEQ : x1;
#pragma unroll
            for (int m = 0; m < 8; ++m) {
                const int t = tid + 512 * m;
                const float r0 = bf2f(x0[t]) * (v[m].x + dd * in0[m]);
                const float r1 = bf2f(x1[t]) * (v[m].y + dd * in1[m]);
                o0[t] = f2bf(r0); o1[t] = f2bf(r1);
            }
        }
    }
    __syncthreads();
}

__device__ __forceinline__ void phase_readout(const Params& p) {
    const int tid = tid_opaque(); const int lane = tid & 63, gwv = blockIdx.x * 8 + (tid >> 6), nw = gridDim.x * 8;
    bf16_t* MIX = (bf16_t*)(p.ws + WS_ABUF);
    const bf16_t* PX = (const bf16_t*)(p.ws + WS_C);
    const int col = (lane >> 3) * 128 + (lane & 7) * 16;
    for (int r = gwv; r < ML; r += nw) {
        bf16_t* mp = MIX + (size_t)r * DM + col;
        const bf16_t* gp = PX + (size_t)r * INC + 4096 + col;
        float o[16], g[16];
#pragma unroll
        for (int hh = 0; hh < 2; ++hh) {
            const u32x4 a = *(const u32x4*)(mp + hh * 8), bq = *(const u32x4*)(mp + 1024 + hh * 8), gg = *(const u32x4*)(gp + hh * 8);
            o[hh * 8 + 0] = bf_lo(a.x) + bf_lo(bq.x); o[hh * 8 + 1] = bf_hi(a.x) + bf_hi(bq.x); o[hh * 8 + 2] = bf_lo(a.y) + bf_lo(bq.y); o[hh * 8 + 3] = bf_hi(a.y) + bf_hi(bq.y);
            o[hh * 8 + 4] = bf_lo(a.z) + bf_lo(bq.z); o[hh * 8 + 5] = bf_hi(a.z) + bf_hi(bq.z); o[hh * 8 + 6] = bf_lo(a.w) + bf_lo(bq.w); o[hh * 8 + 7] = bf_hi(a.w) + bf_hi(bq.w);
            g[hh * 8 + 0] = bf_lo(gg.x); g[hh * 8 + 1] = bf_hi(gg.x); g[hh * 8 + 2] = bf_lo(gg.y); g[hh * 8 + 3] = bf_hi(gg.y);
            g[hh * 8 + 4] = bf_lo(gg.z); g[hh * 8 + 5] = bf_hi(gg.z); g[hh * 8 + 6] = bf_lo(gg.w); g[hh * 8 + 7] = bf_hi(gg.w);
        }
        float ss = 0.f;
#pragma unroll
        for (int i = 0; i < 16; ++i) ss += o[i] * o[i];
        ss += __shfl_xor(ss, 1); ss += __shfl_xor(ss, 2); ss += __shfl_xor(ss, 4);
        const float inv = rsqrtf(ss * (1.0f / 128.0f) + 1e-6f);
        float res[16];
#pragma unroll
        for (int i = 0; i < 16; ++i) res[i] = HG_SCALE * o[i] * inv * p.in[I_HGN][col + i] * siluf_(g[i]);
#pragma unroll
        for (int hh = 0; hh < 2; ++hh) {
            u32x4 w; w.x = cvt_pk_bf16(res[hh * 8 + 0], res[hh * 8 + 1]); w.y = cvt_pk_bf16(res[hh * 8 + 2], res[hh * 8 + 3]); w.z = cvt_pk_bf16(res[hh * 8 + 4], res[hh * 8 + 5]); w.w = cvt_pk_bf16(res[hh * 8 + 6], res[hh * 8 + 7]);
            *(u32x4*)(mp + hh * 8) = w;
        }
    }
}

__device__ __forceinline__ void phase_ytrans(const Params& p, unsigned char* shm) {
    const int tid = tid_opaque();
    float* tile = (float*)shm;
    const bf16_t* UT = (const bf16_t*)(p.ws + WS_F);
    bf16_t* MIX = (bf16_t*)(p.ws + WS_ABUF);
    for (int t = blockIdx.x; t < NB * 64 * 16; t += gridDim.x) {
        const int cgp = t & 15, tb = (t >> 4) & 63, b = t >> 10;
        {
            const int cc = tid >> 3, t8 = (tid & 7) * 8;
            const u32x4 w = *(const u32x4*)(UT + ((size_t)(b * 3072 + cgp * 64 + cc)) * SEQ + tb * 64 + t8);
            float* tp = tile + cc * 65 + t8;
            tp[0] = bf_lo(w.x); tp[1] = bf_hi(w.x); tp[2] = bf_lo(w.y); tp[3] = bf_hi(w.y); tp[4] = bf_lo(w.z); tp[5] = bf_hi(w.z); tp[6] = bf_lo(w.w); tp[7] = bf_hi(w.w);
        }
        __syncthreads();
        {
            const int tt = tid >> 3, c8 = (tid & 7) * 8;
            float e[8];
#pragma unroll
            for (int j = 0; j < 8; ++j) e[j] = HY_SCALE * tile[(c8 + j) * 65 + tt];
            u32x4 w; w.x = cvt_pk_bf16(e[0], e[1]); w.y = cvt_pk_bf16(e[2], e[3]); w.z = cvt_pk_bf16(e[4], e[5]); w.w = cvt_pk_bf16(e[6], e[7]);
            *(u32x4*)(MIX + (size_t)(b * SEQ + tb * 64 + tt) * DM + 1024 + cgp * 64 + c8) = w;
        }
        __syncthreads();
    }
}


#if DEBUG_CHECK
constexpr size_t WS_DBG = WS_END;
__device__ __forceinline__ float rbf(float x) { return bf2f(f2bf(x)); }
__device__ __forceinline__ void dbg_max(const Params& p, int slot, float e) { atomicMax((unsigned*)(p.ws + WS_DBG) + slot, __float_as_uint(e)); }
__device__ __forceinline__ unsigned hsh(unsigned x) { x ^= x >> 16; x *= 0x7feb352du; x ^= x >> 15; x *= 0x846ca68bu; x ^= x >> 16; return x; }
__device__ __forceinline__ float relerr(float got, float ref, float abs_floor) { return fabsf(got - ref) / (fabsf(ref) + abs_floor); }
__device__ __forceinline__ float naive_norm_elem(const float* src, const float* gw, const float* modrow, int sidx, int col) {
    float ss = 0.f; for (int k = 0; k < DM; ++k) ss += src[k] * src[k];
    const float inv = rsqrtf(ss / DM + 1e-6f);
    return src[col] * inv * gw[col] * (1.f + modrow[(sidx + 1) * DM + col]) + modrow[sidx * DM + col];
}
__device__ __forceinline__ void gemm_checks(const Params& p, int which) {
    const unsigned sid = blockIdx.x * 512 + threadIdx.x;
    const unsigned h1 = hsh(sid * 2u + 1u), h2 = hsh(sid * 2u + 2u);
    const float* mod = (const float*)(p.ws + WS_MOD);
    const bf16_t* ABUF = (const bf16_t*)(p.ws + WS_ABUF);
    const bf16_t* CB = (const bf16_t*)(p.ws + WS_C);
    const float* X1C = (const float*)(p.ws + WS_X1C);
    if (which == 1) {
        const int j = h1 % 9, col = h2 % MODC;
        float a = p.in[I_ADAB][col];
        for (int k = 0; k < DM; ++k) { const float cv = (j < 8) ? p.in[I_C][j * DM + k] : p.in[I_CCTX][k]; a += (cv / (1.f + expf(-cv))) * p.in[I_ADAW][(size_t)k * MODC + col]; }
        dbg_max(p, 0, relerr(mod[(size_t)j * MODC + col], a, 0.02f));
    } else if (which == 2 || which == 5 || which == 11) {
        const int nrows = (which == 11) ? ML : MT;
        const int row = h1 % nrows, col = h2 % DM;
        const float* src; const float* gw; int sidx;
        if (which == 2) { src = (row < ML) ? p.in[I_X] + (size_t)row * DM : p.in[I_CTX] + (size_t)(row - ML) * DM; gw = p.in[I_NFFN1]; sidx = 0; }
        else if (which == 5) { src = (row < ML) ? p.out + (size_t)row * DM : X1C + (size_t)(row - ML) * DM; gw = p.in[I_NMIX]; sidx = 3; }
        else { src = p.out + (size_t)row * DM; gw = p.in[I_NFFN2]; sidx = 6; }
        const float* modrow = mod + (size_t)((row < ML) ? (row >> 12) : 8) * MODC;
        const float ref = naive_norm_elem(src, gw, modrow, sidx, col);
        dbg_max(p, (which == 2) ? 1 : (which == 5) ? 4 : 7, relerr(bf2f(ABUF[(size_t)row * DM + col]), ref, 0.05f));
    } else if (which == 3 || which == 12) {
        const int nrows = (which == 12) ? ML : MT;
        const int row = h1 % nrows, hc = h2 % DFF;
        const float* w1 = p.in[(which == 3) ? I_F1W1 : I_F2W1]; const float* w3 = p.in[(which == 3) ? I_F1W3 : I_F2W3];
        float g = 0.f, u = 0.f;
        for (int k = 0; k < DM; ++k) { const float a = bf2f(ABUF[(size_t)row * DM + k]); g += a * rbf(w1[(size_t)k * DFF + hc]); u += a * rbf(w3[(size_t)k * DFF + hc]); }
        const float ref = (g / (1.f + expf(-g))) * u;
        dbg_max(p, (which == 3) ? 2 : 8, relerr(bf2f(CB[(size_t)row * DFF + hc]), ref, 0.05f));
    } else if (which == 4) {
        const int row = h1 % MT, col = h2 % DM;
        float d = 0.f;
        for (int k = 0; k < DFF; ++k) d += bf2f(CB[(size_t)row * DFF + k]) * rbf(p.in[I_F1W2][(size_t)k * DM + col]);
        const float src = (row < ML) ? p.in[I_X][(size_t)row * DM + col] : p.in[I_CTX][(size_t)(row - ML) * DM + col];
        const float gt = mod[(size_t)((row < ML) ? (row >> 12) : 8) * MODC + 2 * DM + col];
        const float ref = src + 0.5f * gt * d;
        const float got = (row < ML) ? p.out[(size_t)row * DM + col] : X1C[(size_t)(row - ML) * DM + col];
        dbg_max(p, 3, relerr(got, ref, 0.05f));
    } else if (which == 6) {
        const bool isc = (sid & 15) == 0;
        const int row = isc ? ML + (h1 % MC) : (h1 % ML), col = isc ? (h2 % 3072) : (h2 % INC);
        float d = 0.f;
        for (int k = 0; k < DM; ++k) d += bf2f(ABUF[(size_t)row * DM + k]) * rbf(p.in[I_WIN][(size_t)k * INC + col]);
        const float got = isc ? bf2f(((const bf16_t*)(p.ws + WS_PXC))[(size_t)(row - ML) * 3072 + col]) : bf2f(CB[(size_t)row * INC + col]);
        dbg_max(p, isc ? 6 : 5, relerr(got, d, 0.05f));
    }
}
#endif

#if ROWCHK
__device__ __forceinline__ float blk_max(float v, float* red) {
    const int tid = threadIdx.x;
    __syncthreads(); red[tid] = v; __syncthreads();
    float m = 0.f; for (int i = 0; i < 512; ++i) m = fmaxf(m, red[i]);
    __syncthreads();
    return m;
}
__device__ __forceinline__ float blk_sum(float v, float* red) {
    const int tid = threadIdx.x;
    __syncthreads(); red[tid] = v; __syncthreads();
    float m = 0.f; for (int i = 0; i < 512; ++i) m += red[i];
    __syncthreads();
    return m;
}
__device__ __forceinline__ void rc_norm(const float* src, const float* gw, const float* modb, int sidx, float* hrow, float* red) {
    const int tid = threadIdx.x;
    float ss = 0.f; for (int c = tid; c < DM; c += 512) ss += src[c] * src[c];
    __syncthreads(); red[tid] = ss; __syncthreads();
    float t = 0.f; for (int i = 0; i < 512; ++i) t += red[i];
    const float inv = 1.0f / sqrtf(t / DM + 1e-6f);
    for (int c = tid; c < DM; c += 512) hrow[c] = src[c] * inv * gw[c] * (1.f + modb[(sidx + 1) * DM + c]) + modb[sidx * DM + c];
    __syncthreads();
}
__device__ __forceinline__ void rc_ffn(const float* hrow, float* hid, const float* w1, const float* w3) {
    const int tid = threadIdx.x;
    for (int j = tid; j < DFF; j += 512) {
        float g = 0.f, u = 0.f;
        for (int k = 0; k < DM; ++k) { g += hrow[k] * w1[(size_t)k * DFF + j]; u += hrow[k] * w3[(size_t)k * DFF + j]; }
        hid[j] = (g / (1.f + expf(-g))) * u;
    }
    __syncthreads();
}
__device__ __forceinline__ void row_checks(const Params& p, int which, unsigned char* shm) {
    float* hrow = (float*)shm; float* hid = hrow + 2048; float* red = hid + 5632;
    const int tid = threadIdx.x, bid = blockIdx.x;
    const int row = bid * 128 + ((bid * 37) & 127);
    const float* modb = (const float*)(p.ws + WS_MOD) + (size_t)(row >> 12) * MODC;
    float* dbg = (float*)(p.ws + WS_MODP);
    float* save = dbg + 4096 + (size_t)bid * 2048;
    float e = 0.f, r2 = 0.f;
    if (which == 0 && bid >= 999) {
        const int rc = (bid - 192) * 32 + 7;
        const float* modc = (const float*)(p.ws + WS_MOD) + (size_t)8 * MODC;
        const float* X1Cc = (const float*)(p.ws + WS_X1C);
        rc_norm(p.in[I_CTX] + (size_t)rc * DM, p.in[I_NFFN1], modc, 0, hrow, red);
        rc_ffn(hrow, hid, p.in[I_F1W1], p.in[I_F1W3]);
        for (int c = tid; c < DM; c += 512) { float d = 0.f; for (int j = 0; j < DFF; ++j) d += hid[j] * p.in[I_F1W2][(size_t)j * DM + c];
            const float ref = p.in[I_CTX][(size_t)rc * DM + c] + 0.5f * modc[2 * DM + c] * d; { const float df = X1Cc[(size_t)rc * DM + c] - ref; e += df * df; r2 += ref * ref; } }
        e = blk_sum(e, red); r2 = blk_sum(r2, red); if (tid == 0) { dbg[5 * 256 + bid] = e; dbg[2048 + 5 * 256 + bid] = r2; }
    } else if (which == 1 && bid >= 999) {
        const int rc = (bid - 192) * 32 + 7;
        const float* modc = (const float*)(p.ws + WS_MOD) + (size_t)8 * MODC;
        rc_norm((const float*)(p.ws + WS_X1C) + (size_t)rc * DM, p.in[I_NMIX], modc, 3, hrow, red);
        const bf16_t* PXCc = (const bf16_t*)(p.ws + WS_PXC);
        for (int c = tid; c < 3072; c += 512) { float d = 0.f; for (int k = 0; k < DM; ++k) d += hrow[k] * p.in[I_WIN][(size_t)k * INC + c];
            { const float df = bf2f(PXCc[(size_t)rc * 3072 + c]) - d; e += df * df; r2 += d * d; } }
        e = blk_sum(e, red); r2 = blk_sum(r2, red); if (tid == 0) { dbg[7 * 256 + bid] = e; dbg[2048 + 7 * 256 + bid] = r2; }
    } else if (which == 0) {
        rc_norm(p.in[I_X] + (size_t)row * DM, p.in[I_NFFN1], modb, 0, hrow, red);
        rc_ffn(hrow, hid, p.in[I_F1W1], p.in[I_F1W3]);
        for (int c = tid; c < DM; c += 512) { float d = 0.f; for (int j = 0; j < DFF; ++j) d += hid[j] * p.in[I_F1W2][(size_t)j * DM + c];
            const float ref = p.in[I_X][(size_t)row * DM + c] + 0.5f * modb[2 * DM + c] * d; { const float df = p.out[(size_t)row * DM + c] - ref; e += df * df; r2 += ref * ref; } }
        e = blk_sum(e, red); r2 = blk_sum(r2, red); if (tid == 0) { dbg[0 * 256 + bid] = e; dbg[2048 + 0 * 256 + bid] = r2; }
    } else if (which == 1) {
        rc_norm(p.out + (size_t)row * DM, p.in[I_NMIX], modb, 3, hrow, red);
        const bf16_t* PX = (const bf16_t*)(p.ws + WS_C);
        for (int c = tid; c < INC; c += 512) { float d = 0.f; for (int k = 0; k < DM; ++k) d += hrow[k] * p.in[I_WIN][(size_t)k * INC + c];
            { const float df = bf2f(PX[(size_t)row * INC + c]) - d; e += df * df; r2 += d * d; } }
        e = blk_sum(e, red); r2 = blk_sum(r2, red); if (tid == 0) { dbg[1 * 256 + bid] = e; dbg[2048 + 1 * 256 + bid] = r2; }
    } else if (which == 2) {
        const bf16_t* MIX = (const bf16_t*)(p.ws + WS_ABUF);
        for (int c = tid; c < DM; c += 512) { float d = 0.f; for (int k = 0; k < DM; ++k) d += bf2f(MIX[(size_t)row * DM + k]) * p.in[I_WOUT][(size_t)k * DM + c];
            save[c] = p.out[(size_t)row * DM + c] + modb[5 * DM + c] * d; }
    } else if (which == 3) {
        for (int c = tid; c < DM; c += 512) { const float df = p.out[(size_t)row * DM + c] - save[c]; e += df * df; r2 += save[c] * save[c]; }
        e = blk_sum(e, red); r2 = blk_sum(r2, red); if (tid == 0) { dbg[2 * 256 + bid] = e; dbg[2048 + 2 * 256 + bid] = r2; }
        rc_norm(p.out + (size_t)row * DM, p.in[I_NFFN2], modb, 6, hrow, red);
        rc_ffn(hrow, hid, p.in[I_F2W1], p.in[I_F2W3]);
        for (int c = tid; c < DM; c += 512) { float d = 0.f; for (int j = 0; j < DFF; ++j) d += hid[j] * p.in[I_F2W2][(size_t)j * DM + c];
            save[c] = p.out[(size_t)row * DM + c] + 0.5f * modb[8 * DM + c] * d; }
    } else if (which == 4) {
        for (int c = tid; c < DM; c += 512) { const float df = p.out[(size_t)row * DM + c] - save[c]; e += df * df; r2 += save[c] * save[c]; }
        e = blk_sum(e, red); r2 = blk_sum(r2, red); if (tid == 0) { dbg[3 * 256 + bid] = e; dbg[2048 + 3 * 256 + bid] = r2; }
        float ss = 0.f; for (int c = tid; c < DM; c += 512) ss += p.out[(size_t)row * DM + c] * p.out[(size_t)row * DM + c];
        __syncthreads(); red[tid] = ss; __syncthreads();
        float t = 0.f; for (int i = 0; i < 512; ++i) t += red[i];
        const float inv = 1.0f / sqrtf(t / DM + 1e-6f);
        for (int c = tid; c < DM; c += 512) save[c] = p.out[(size_t)row * DM + c] * inv * p.in[I_FNORM][c];
    } else if (which == 5) {
        for (int c = tid; c < DM; c += 512) { const float df = p.out[(size_t)row * DM + c] - save[c]; e += df * df; r2 += save[c] * save[c]; }
        e = blk_sum(e, red); r2 = blk_sum(r2, red); if (tid == 0) { dbg[4 * 256 + bid] = e; dbg[2048 + 4 * 256 + bid] = r2; }
    } else if (which == 10) {
        const bf16_t* PX = (const bf16_t*)(p.ws + WS_C); const bf16_t* PXC = (const bf16_t*)(p.ws + WS_PXC); const bf16_t* MIX = (const bf16_t*)(p.ws + WS_ABUF);
        float* SL = (float*)shm;
        float* lbs = SL + 128 * 64;
        const int b = bid & 7, h = (bid >> 3) & 7, dir = (bid >> 6) & 1, v = (bid >> 7) * 64 + (tid & 63);
        if (tid < 128) { const int j = h * 128 + tid; lbs[tid] = sigmoidf_(p.in[I_LB][dir * 2048 + j] - p.in[I_LB][dir * 2048 + 1024 + j]); }
        __syncthreads();
        if (tid < 64) {
            for (int k = 0; k < 128; ++k) SL[k * 64 + tid] = 0.f;
            for (int step = 0; step < CTXL + SEQ; ++step) {
                const bool lat = step >= CTXL;
                const int q = lat ? step - CTXL : step;
                const bf16_t* rowp; int rw;
                if (!lat) { rw = b * CTXL + (dir ? CTXL - 1 - q : q); rowp = PXC + (size_t)rw * 3072; }
                else { rw = b * SEQ + (dir ? SEQ - 1 - q : q); rowp = PX + (size_t)rw * INC; }
                const float vv = bf2f(rowp[2048 + h * 128 + v]);
                float o = 0.f;
#pragma unroll 4
                for (int k = 0; k < 128; ++k) {
                    const float f = lbs[k] + (1.f - lbs[k]) * sigmoidf_(bf2f(rowp[dir * 1024 + h * 128 + k]));
                    const float sn = f * SL[k * 64 + tid] + (1.f - f) * vv;
                    SL[k * 64 + tid] = sn;
                    if (lat) o += sn * bf2f(rowp[3072 + h * 128 + k]) * 0.08838834764831845f;
                }
                if (lat) { const float got = bf2f(MIX[(size_t)rw * DM + dir * 1024 + h * 128 + v]); const float df = got - o; e += df * df; r2 += o * o; }
            }
        }
        e = blk_sum(e, red + 8192); r2 = blk_sum(r2, red + 8192); if (tid == 0) { dbg[528384 + bid] = e; dbg[528640 + bid] = r2; }
    } else if (which == 8) {
        const bf16_t* MIX = (const bf16_t*)(p.ws + WS_ABUF); const bf16_t* PX = (const bf16_t*)(p.ws + WS_C);
        for (int c = tid; c < 1024; c += 512) hrow[c] = bf2f(MIX[(size_t)row * DM + c]) + bf2f(MIX[(size_t)row * DM + 1024 + c]);
        __syncthreads();
        for (int c = tid; c < 1024; c += 512) { const int h0 = c & ~127; float ss = 0.f; for (int k = 0; k < 128; ++k) ss += hrow[h0 + k] * hrow[h0 + k];
            const float g = bf2f(PX[(size_t)row * INC + 4096 + c]);
            save[c] = hrow[c] / sqrtf(ss / 128.f + 1e-6f) * p.in[I_HGN][c] * (g / (1.f + expf(-g))); }
    } else if (which == 9) {
        const bf16_t* MIX = (const bf16_t*)(p.ws + WS_ABUF);
        for (int c = tid; c < 1024; c += 512) { const float df = bf2f(MIX[(size_t)row * DM + c]) - save[c]; e += df * df; r2 += save[c] * save[c]; }
        e = blk_sum(e, red); r2 = blk_sum(r2, red); if (tid == 0) { dbg[6 * 256 + bid] = e; dbg[2048 + 6 * 256 + bid] = r2; }
    } else if (which == 6) {
        if (bid == 0 && tid == 0) { float code = 0.f; for (int i = 0; i < 8; ++i) { float se = 0.f, sr = 0.f; for (int j = 0; j < 256; ++j) { const bool use = (i != 5 && i != 7); if (use) { se += dbg[i * 256 + j]; sr += dbg[2048 + i * 256 + j]; } } if (se > ROWCHK_TOL * sr) code += (float)(1 << i); } { for (int j = 0; j < 256; ++j) if (false && dbg[528384 + j] / (dbg[528640 + j] + 1e-20f) > HGCHK_TOL) code += 1.f; } p.out[0] += 10.f * code; }
    }
}
#endif

__global__ __launch_bounds__(512, 2) void mega(Params p) {
    extern __shared__ __attribute__((aligned(16))) unsigned char shm[];
    cg::grid_group grid = cg::this_grid();
    const int G = gridDim.x, bid = blockIdx.x;
    LAS unsigned char* lds = (LAS unsigned char*)shm;
    float* mod = (float*)(p.ws + WS_MOD);
    bf16_t* ABUF = (bf16_t*)(p.ws + WS_ABUF);
    bf16_t* CB = (bf16_t*)(p.ws + WS_C);
    float* X1C = (float*)(p.ws + WS_X1C);
#if ROWCHK
    if (p.ph_lo >= 300) { row_checks(p, p.ph_lo - 300, shm); return; }
#endif
#if DEBUG_CHECK
    if (p.ph_lo >= 100 && p.ph_lo < 200) { gemm_checks(p, p.ph_lo - 100); return; }
    if (p.ph_lo == 200) {
        if (blockIdx.x == 0 && threadIdx.x == 0) { const float* d = (const float*)(p.ws + WS_DBG); float code = 0.f; for (int i = 0; i < 9; ++i) if (d[i] > 0.03f) code += (float)(1 << i); p.out[0] += 10.f * code; }
        return;
    }
#endif
#if DEBUG_CHECK
        if (p.ph_lo == 0 && blockIdx.x == 0 && threadIdx.x < 16) ((unsigned*)(p.ws + WS_DBG))[threadIdx.x] = 0u;
#endif
        PHASE_BEGIN(0) phase_prep(p, shm);
        PHASE_BEGIN(1) { }
        PHASE_BEGIN(2) phase_norm(p, p.in[I_X], p.in[I_CTX], MT, p.in[I_NFFN1], 0);
        PHASE_BEGIN(3) {
            pg8::Gemm g{ABUF, (const bf16_t*)(p.ws + WS_W13A), MT, 2 * DFF, DM};
            pg8::StaticOrder S; S.init(g.M, g.N, G, bid, 0);
            EpiSwiGLU E{CB};
            GEMM_RUN(3, g, S, E);
        } PHASE_BEGIN(4) {
            pg8::Gemm g{CB, (const bf16_t*)(p.ws + WS_W2A), MT, DM, DFF};
            pg8::StaticOrder S; S.init(g.M, g.N, G, bid, 0);
            EpiRes E{p.in[I_X], p.out, p.in[I_CTX], X1C, mod + 2 * DM, 0.5f};
            GEMM_RUN(4, g, S, E);
        } PHASE_BEGIN(5) phase_norm(p, p.out, X1C, MT, p.in[I_NMIX], 3);
        PHASE_BEGIN(6) {
            pg8::Gemm g{ABUF, (const bf16_t*)(p.ws + WS_WIN), ML, INC, DM};
            pg8::StaticOrder S; S.init(g.M, g.N, G, bid, 96);
            EpiBf16 E{CB, INC, (bf16_t*)(p.ws + WS_PXC), 3072};
            GEMM_RUN(6, g, S, E);
        } PHASE_BEGIN(7) {
            phase_shortconv(p, shm);
            for (int it = bid; it < 256; it += G) hgrn_item(p, it, shm);
        } PHASE_BEGIN(8) {
            for (int c = bid; c < 1024; c += G) hyena_item(p, c, shm);
            phase_readout(p);
        } PHASE_BEGIN(9) phase_ytrans(p, shm);
        PHASE_BEGIN(10) {
            pg8::Gemm g{ABUF, (const bf16_t*)(p.ws + WS_WOUT), ML, DM, DM};
            pg8::StaticOrder S; S.init(g.M, g.N, G, bid, 0);
            EpiRes E{p.out, p.out, nullptr, nullptr, mod + 5 * DM, 1.0f};
            GEMM_RUN(10, g, S, E);
        } PHASE_BEGIN(11) phase_norm(p, p.out, nullptr, ML, p.in[I_NFFN2], 6);
        PHASE_BEGIN(12) {
            pg8::Gemm g{ABUF, (const bf16_t*)(p.ws + WS_W13B), ML, 2 * DFF, DM};
            pg8::StaticOrder S; S.init(g.M, g.N, G, bid, 0);
            EpiSwiGLU E{CB};
            GEMM_RUN(12, g, S, E);
        } PHASE_BEGIN(13) {
            pg8::Gemm g{CB, (const bf16_t*)(p.ws + WS_W2B), ML, DM, DFF};
            pg8::StaticOrder S; S.init(g.M, g.N, G, bid, 0);
            EpiRes E{p.out, p.out, nullptr, nullptr, mod + 8 * DM, 0.5f};
            GEMM_RUN(13, g, S, E);
        } PHASE_BEGIN(14) phase_final_norm(p);
}

extern "C" void kernel_launch(void* const* d_in, const int* in_sizes, int n_in, void* d_out, int out_size, void* d_ws, size_t ws_size, hipStream_t stream) {
    static int grid_blocks = 0;
    if (grid_blocks == 0) {
        if (n_in != 31 || out_size != ML * DM || ws_size < WS_END + 64) { fprintf(stderr, "kernel_launch: unexpected shapes (n_in %d out %d ws %zu need %zu)\n", n_in, out_size, ws_size, (size_t)WS_END); grid_blocks = -1; return; }
        int dev = 0, cus = 0, per_cu = 0;
        hipGetDevice(&dev);
        hipDeviceGetAttribute(&cus, hipDeviceAttributeMultiprocessorCount, dev);
        if (hipFuncSetAttribute((const void*)mega, hipFuncAttributeMaxDynamicSharedMemorySize, LDS_BYTES) != hipSuccess) { fprintf(stderr, "kernel_launch: hipFuncSetAttribute failed\n"); grid_blocks = -1; return; }
        if (hipOccupancyMaxActiveBlocksPerMultiprocessor(&per_cu, (const void*)mega, 512, LDS_BYTES) != hipSuccess || per_cu < 1) { fprintf(stderr, "kernel_launch: occupancy query failed (%d)\n", per_cu); per_cu = 1; (void)hipGetLastError(); }
        grid_blocks = cus * per_cu;
    }
    if (grid_blocks < 0) return;
    Params p;
    memset(&p, 0, sizeof(p));
    for (int i = 0; i < 31; ++i) p.in[i] = (const float*)d_in[i];
    p.out = (float*)d_out; p.ws = (unsigned char*)d_ws;
#if MULTI_LAUNCH
    for (int ph = 0; ph < NPH; ++ph) {
        p.ph_lo = ph; p.ph_hi = ph + 1;
        hipLaunchKernelGGL(mega, dim3(grid_blocks), dim3(512), LDS_BYTES, stream, p);
#if ROWCHK
        { const int w = (ph == 4) ? 0 : (ph == 6) ? 1 : (ph == 7) ? 8 : (ph == 8) ? 9 : (ph == 9) ? 2 : (ph == 10) ? 3 : (ph == 13) ? 4 : (ph == 14) ? 5 : -1;
          if (w >= 0) { p.ph_lo = 300 + w; p.ph_hi = 301 + w; hipLaunchKernelGGL(mega, dim3(256), dim3(512), LDS_BYTES, stream, p); }
          if (ph == 7) { p.ph_lo = 310; p.ph_hi = 311; hipLaunchKernelGGL(mega, dim3(256), dim3(512), LDS_BYTES, stream, p); }
          if (ph == 14) { p.ph_lo = 306; p.ph_hi = 307; hipLaunchKernelGGL(mega, dim3(256), dim3(512), LDS_BYTES, stream, p); } }
#endif
#if DEBUG_CHECK
        if (DBG_MASK & (1 << ph)) { p.ph_lo = 100 + ph; p.ph_hi = 101 + ph; hipLaunchKernelGGL(mega, dim3(grid_blocks), dim3(512), LDS_BYTES, stream, p); }
        if (ph == NPH - 1) { p.ph_lo = 200; p.ph_hi = 201 + DBG_SLOT; hipLaunchKernelGGL(mega, dim3(grid_blocks), dim3(512), LDS_BYTES, stream, p); }
#endif
    }
#else
    p.ph_lo = 0; p.ph_hi = NPH;
    void* args[] = {&p};
    hipError_t e = hipLaunchCooperativeKernel((const void*)mega, dim3(grid_blocks), dim3(512), args, LDS_BYTES, stream);
    if (e != hipSuccess) fprintf(stderr, "cooperative launch failed: %s (grid %d)\n", hipGetErrorString(e), grid_blocks);
#endif
}
```

```cpp
#include <hip/hip_runtime.h>
#include <hip/hip_cooperative_groups.h>
#include <cstdio>
#include <cstring>
namespace cg = cooperative_groups;

#ifndef ONLY_PH
#define ONLY_PH -1
#endif
#define PH(n) (p.ph_lo <= (n) && (n) < p.ph_hi && (ONLY_PH < 0 || ONLY_PH == (n)))
#define PHASE_BEGIN(n) if (p.ph_lo < (n) && (n) < p.ph_hi) { grid.sync(); if (TSEL) { const unsigned long long now_ = wall_clock64(); if (TSEL & (1 << ((n) - 1))) tacc += now_ - tprev; tprev = now_; } } if (PH(n))
#ifndef HY_SCALE
#define HY_SCALE 1.0f
#endif
#ifndef HG_SCALE
#define HG_SCALE 1.0f
#endif
#ifndef SKIP_CTX
#define SKIP_CTX 0
#endif
#ifndef DEBUG_CHECK
#define DEBUG_CHECK 0
#endif
#ifndef DBG_SLOT
#define DBG_SLOT 0
#endif
#ifndef DBG_MASK
#define DBG_MASK 0x0
#endif
#ifndef SIMPLE_GEMM
#define SIMPLE_GEMM 0x0
#endif
#ifndef FN_NOGAIN
#define FN_NOGAIN 0
#endif
#ifndef ROWCHK
#define ROWCHK 0
#endif
#ifndef ROWCHK_TOL
#define ROWCHK_TOL 1e-5f
#endif
#ifndef HGCHK_TOL
#define HGCHK_TOL 1e-4f
#endif
#ifndef TSEL
#define TSEL 0
#endif
#ifndef HG_MFMA
#define HG_MFMA 1
#endif
#ifndef MULTI_LAUNCH
#define MULTI_LAUNCH 0
#endif

#define LAS __attribute__((address_space(3)))
typedef unsigned short bf16_t;
typedef short bf16x8 __attribute__((ext_vector_type(8)));
typedef float f32x4 __attribute__((ext_vector_type(4)));
typedef unsigned u32x4 __attribute__((ext_vector_type(4)));
typedef unsigned u32x2 __attribute__((ext_vector_type(2)));

constexpr int DM = 2048, NB = 8, SEQ = 4096, CTXL = 256, DFF = 5632, MODC = 18432, HGW = 1024, INC = 8192;
constexpr int ML = NB * SEQ, MC = NB * CTXL, MT = ML + MC;
constexpr int NPH = 15;
constexpr int LDS_BYTES = 131072;

constexpr size_t WS_WIN = 0;
constexpr size_t WS_WOUT = WS_WIN + (size_t)INC * DM * 2;
constexpr size_t WS_W13B = WS_WOUT + (size_t)DM * DM * 2;
constexpr size_t WS_W2B = WS_W13B + (size_t)2 * DFF * DM * 2;
constexpr size_t WS_MODP = WS_W2B + (size_t)DM * DFF * 2;
constexpr size_t WS_MOD = WS_MODP + (size_t)8 * 9 * MODC * 4;
constexpr size_t WS_HID3 = WS_MOD + (size_t)9 * MODC * 4;
constexpr size_t WS_X1C = WS_HID3 + (size_t)64 * 4096 * 4;
constexpr size_t WS_PXC = WS_X1C + (size_t)MC * DM * 4;
constexpr size_t WS_ABUF = WS_PXC + (size_t)MC * 3072 * 2;
constexpr size_t WS_C = WS_ABUF + (size_t)MT * DM * 2;
constexpr size_t WS_F = WS_C + (size_t)ML * INC * 2;
constexpr size_t WS_W13A = WS_F;
constexpr size_t WS_W2A = WS_W13A + (size_t)2 * DFF * DM * 2;
constexpr size_t WS_END = WS_F + (size_t)NB * 3072 * SEQ * 2;
static_assert((size_t)MT * DFF * 2 <= (size_t)ML * INC * 2, "H fits in region C");

struct Params {
    const float* in[31];
    float* out;
    unsigned char* ws;
    int ph_lo, ph_hi;
};
enum { I_X = 0, I_C, I_CTX, I_CCTX, I_ADAW, I_ADAB, I_NFFN1, I_F1W1, I_F1W3, I_F1W2, I_NMIX, I_WIN, I_LB, I_HGN, I_HCW, I_HCB, I_FW1, I_FB1, I_FW2, I_FB2, I_FW3, I_FB3, I_FFREQ, I_FWO, I_HYD, I_WOUT, I_NFFN2, I_F2W1, I_F2W3, I_F2W2, I_FNORM };

__device__ __forceinline__ unsigned cvt_pk_bf16(float lo, float hi) { unsigned r; asm volatile("v_cvt_pk_bf16_f32 %0, %1, %2" : "=v"(r) : "v"(lo), "v"(hi)); return r; }
typedef __bf16 bf16v2_t __attribute__((ext_vector_type(2)));
typedef float f32x2_t __attribute__((ext_vector_type(2)));
__device__ __forceinline__ unsigned cvt_pk_safe(float lo, float hi) { const f32x2_t v = {lo, hi}; const bf16v2_t b = __builtin_convertvector(v, bf16v2_t); return __builtin_bit_cast(unsigned, b); }
__device__ __forceinline__ float bf_lo(unsigned w) { return __uint_as_float(w << 16); }
__device__ __forceinline__ float bf_hi(unsigned w) { return __uint_as_float(w & 0xffff0000u); }
__device__ __forceinline__ float bf2f(bf16_t h) { return __uint_as_float(((unsigned)h) << 16); }
__device__ __forceinline__ bf16_t f2bf(float f) { return (bf16_t)(cvt_pk_bf16(f, 0.f) & 0xffffu); }
__device__ __forceinline__ float sigmoidf_(float x) { return __builtin_amdgcn_rcpf(1.0f + __expf(-x)); }
__device__ __forceinline__ float siluf_(float x) { return x * sigmoidf_(x); }
__device__ __forceinline__ int tid_opaque() { int t = threadIdx.x; asm volatile("" : "+v"(t)); return t; }
#define HW_COS(r) __builtin_amdgcn_cosf(r)
#define HW_SIN(r) __builtin_amdgcn_sinf(r)
#define SYNC() __syncthreads()
__device__ __forceinline__ float sin_rad(float a) { float r = a * 0.15915494309189535f; r -= rintf(r); return HW_SIN(r); }
__device__ __forceinline__ float cos_rad(float a) { float r = a * 0.15915494309189535f; r -= rintf(r); return HW_COS(r); }
__device__ __forceinline__ float wave_sum(float v) {
#pragma unroll
    for (int o = 32; o > 0; o >>= 1) v += __shfl_xor(v, o);
    return v;
}

#define FPAD(i) ((i) + (((i) >> 5) << 1))
#define FFT_LDS_ELEMS 8704
__device__ __forceinline__ float2 cadd(float2 a, float2 b) { return make_float2(a.x + b.x, a.y + b.y); }
__device__ __forceinline__ float2 csub(float2 a, float2 b) { return make_float2(a.x - b.x, a.y - b.y); }
__device__ __forceinline__ float2 cmul(float2 a, float2 b) { return make_float2(a.x * b.x - a.y * b.y, a.x * b.y + a.y * b.x); }
__device__ __forceinline__ float2 cmulc(float2 a, float2 b) { return make_float2(a.x * b.x + a.y * b.y, a.y * b.x - a.x * b.y); }
__device__ __forceinline__ float2 twid(float rev) { return make_float2(HW_COS(rev), -HW_SIN(rev)); }

template <int K> struct W16 {
    static constexpr float X = (K == 0) ? 1.f : (K == 1) ? 0.92387953251f : (K == 2) ? 0.70710678119f : (K == 3) ? 0.38268343237f : (K == 4) ? 0.f : (K == 5) ? -0.38268343237f : (K == 6) ? -0.70710678119f : -0.92387953251f;
    static constexpr float Y = (K == 0) ? 0.f : (K == 1) ? -0.38268343237f : (K == 2) ? -0.70710678119f : (K == 3) ? -0.92387953251f : (K == 4) ? -1.f : (K == 5) ? -0.92387953251f : (K == 6) ? -0.70710678119f : -0.38268343237f;
};

template <int U, int ML_, bool INV> __device__ __forceinline__ void fft_bfly_group(float2 (&v)[16], float2 Tu) {
    constexpr int half = 8 >> U;
    const float2 tw = (ML_ == 0) ? Tu : cmul(Tu, make_float2(W16<(ML_ << U)>::X, W16<(ML_ << U)>::Y));
#pragma unroll
    for (int bs = 0; bs < 16; bs += 2 * half) {
        const int m = bs + ML_;
        if (!INV) { const float2 a = v[m], b = v[m + half]; v[m] = cadd(a, b); v[m + half] = cmul(csub(a, b), tw); }
        else { const float2 a = v[m], b = cmulc(v[m + half], tw); v[m] = cadd(a, b); v[m + half] = csub(a, b); }
    }
}
template <int U, bool INV> __device__ __forceinline__ void fft_stage(float2 (&v)[16], float2 Tu) {
    constexpr int half = 8 >> U;
    fft_bfly_group<U, 0, INV>(v, Tu);
    if constexpr (half > 1) fft_bfly_group<U, 1, INV>(v, Tu);
    if constexpr (half > 2) { fft_bfly_group<U, 2, INV>(v, Tu); fft_bfly_group<U, 3, INV>(v, Tu); }
    if constexpr (half > 4) { fft_bfly_group<U, 4, INV>(v, Tu); fft_bfly_group<U, 5, INV>(v, Tu); fft_bfly_group<U, 6, INV>(v, Tu); fft_bfly_group<U, 7, INV>(v, Tu); }
}
template <int P, bool INV> __device__ __forceinline__ void fft16(float2 (&v)[16], int L) {
    const float sc = 1.0f / (float)(1 << (P + 4));
    const float2 T0 = twid((float)L * sc), T1 = twid((float)(L << 1) * sc), T2 = twid((float)(L << 2) * sc), T3 = twid((float)(L << 3) * sc);
    if (!INV) { fft_stage<0, false>(v, T0); fft_stage<1, false>(v, T1); fft_stage<2, false>(v, T2); fft_stage<3, false>(v, T3); }
    else { fft_stage<3, true>(v, T3); fft_stage<2, true>(v, T2); fft_stage<1, true>(v, T1); fft_stage<0, true>(v, T0); }
}
__device__ __forceinline__ int fidxA(int tid, int m) { return tid + 512 * m; }
__device__ __forceinline__ int fidxB(int tid, int m) { return ((tid >> 5) << 9) + (m << 5) + (tid & 31); }
__device__ __forceinline__ int fidxC(int tid, int m) { return ((tid >> 1) << 5) + (m << 1) + (tid & 1); }

#define FFT_FWD_TO_PAIRS(v, buf, tid_) do { int ftid = (tid_); asm volatile("" : "+v"(ftid)); \
    fft16<9, false>(v, ftid); \
    _Pragma("unroll") for (int m = 0; m < 16; ++m) buf[FPAD(fidxA(ftid, m))] = v[m]; \
    SYNC(); \
    _Pragma("unroll") for (int m = 0; m < 16; ++m) v[m] = buf[FPAD(fidxB(ftid, m))]; \
    fft16<5, false>(v, ftid & 31); \
    _Pragma("unroll") for (int m = 0; m < 16; ++m) buf[FPAD(fidxB(ftid, m))] = v[m]; \
    SYNC(); \
    _Pragma("unroll") for (int m = 0; m < 16; ++m) v[m] = buf[FPAD(fidxC(ftid, m))]; \
    fft16<1, false>(v, ftid & 1); \
    _Pragma("unroll") for (int m = 0; m < 16; ++m) buf[FPAD(fidxC(ftid, m))] = v[m]; \
    SYNC(); \
    _Pragma("unroll") for (int q = 0; q < 8; ++q) { const int j2 = 2 * (ftid + 512 * q); const float4 pr = *(const float4*)&buf[FPAD(j2)]; \
        v[2 * q] = make_float2(pr.x + pr.z, pr.y + pr.w); v[2 * q + 1] = make_float2(pr.x - pr.z, pr.y - pr.w); } \
} while (0)

#define FFT_INV_FROM_PAIRS(v, buf, tid_) do { int ftid = (tid_); asm volatile("" : "+v"(ftid)); \
    _Pragma("unroll") for (int q = 0; q < 8; ++q) { const int j2 = 2 * (ftid + 512 * q); const float2 a = v[2 * q], b = v[2 * q + 1]; \
        *(float4*)&buf[FPAD(j2)] = make_float4(a.x + b.x, a.y + b.y, a.x - b.x, a.y - b.y); } \
    SYNC(); \
    _Pragma("unroll") for (int m = 0; m < 16; ++m) v[m] = buf[FPAD(fidxC(ftid, m))]; \
    fft16<1, true>(v, ftid & 1); \
    _Pragma("unroll") for (int m = 0; m < 16; ++m) buf[FPAD(fidxC(ftid, m))] = v[m]; \
    SYNC(); \
    _Pragma("unroll") for (int m = 0; m < 16; ++m) v[m] = buf[FPAD(fidxB(ftid, m))]; \
    fft16<5, true>(v, ftid & 31); \
    _Pragma("unroll") for (int m = 0; m < 16; ++m) buf[FPAD(fidxB(ftid, m))] = v[m]; \
    SYNC(); \
    _Pragma("unroll") for (int m = 0; m < 16; ++m) v[m] = buf[FPAD(fidxA(ftid, m))]; \
    fft16<9, true>(v, ftid); \
} while (0)

namespace pg8 {
constexpr int BM = 256, BK = 64, HALF = 128, HTB = HALF * BK * 2, STAGE_BYTES = 8 * HTB, NXCD = 8, WGM = 8;
__device__ __forceinline__ int lds_byte(int r, int c) { const int st = (r >> 4) * 2 + (c >> 5), rr = r & 15, cc = c & 31, ob = rr * 64 + cc * 2; return st * 1024 + (ob ^ (((ob >> 9) & 1) << 5)); }
__device__ __forceinline__ void stage_rc(int b, int& R, int& C) { const int st = b / 1024, sb = b % 1024, swz = sb ^ (((sb >> 9) & 1) << 5); R = (st >> 1) * 16 + swz / 64; C = (st & 1) * 32 + (swz % 64) / 2; }
__device__ __forceinline__ int perm32(int rho) { const int n = rho >> 4, i = rho & 15; return 8 * (i >> 2) + 4 * n + (i & 3); }
struct Unit { int pm, pn; };
struct Gemm { const bf16_t* A; const bf16_t* Bt; int M, N, K; };
struct StaticOrder {
    int nM, nN, nwg, G, c, extra;
    __device__ void init(int M, int N, int G_, int c_, int extra_) { nM = M / BM; nN = N / BM; nwg = nM * nN; G = G_; c = c_; extra = extra_; }
    __device__ bool next(int i, Unit& u) const {
        const long L = (long)i * G + c;
        if (L >= nwg) { const int e = (int)(L - nwg); if (e >= extra) return false; u.pm = 128 + (e & 7); u.pn = e >> 3; return true; }
        int wgid = (int)L; { const int q = nwg / NXCD, r = nwg % NXCD, xcd = wgid % NXCD, off = wgid / NXCD; wgid = (xcd < r ? xcd * (q + 1) : r * (q + 1) + (xcd - r) * q) + off; }
        const int nig = WGM * nN, gid = wgid / nig, fm = gid * WGM, gsz = (nM - fm) < WGM ? (nM - fm) : WGM;
        u.pm = fm + ((wgid % nig) % gsz); u.pn = (wgid % nig) / gsz; return true;
    }
    __device__ __forceinline__ void a_ready(const Unit&) const {}
    __device__ __forceinline__ void done(const Unit&) const {}
};

template <class Epi, class Sched>
__device__ __forceinline__ void gemm_phase(LAS unsigned char* lds, const Gemm g, const Sched& S, const Epi& E) {
    const int tid = tid_opaque(), wid = __builtin_amdgcn_readfirstlane(tid >> 6), lane = tid & 63, wr = wid >> 2, wc = wid & 3, fr = lane & 15, fq = lane >> 4;
    const int K = g.K, nt = K / BK;
    unsigned voffA[2], voffB[2];
#pragma unroll
    for (int i = 0; i < 2; ++i) { int R, C; stage_rc(tid * 16 + i * 8192, R, C); const int Rb = Epi::PERM ? ((R & ~31) + perm32(R & 31)) : R;
        voffA[i] = (unsigned)(R * K + C) * 2u; voffB[i] = (unsigned)(Rb * K + C) * 2u; }
    const size_t kstep = (size_t)(BK * 2);
    const size_t hstep = (size_t)HALF * K * 2;
    const size_t tstep = 2 * hstep;
    const unsigned ldsw = (unsigned)wid * 1024u;
    const int aoff = lds_byte(wr * 64 + fr, fq * 8), boff = lds_byte(wc * 32 + fr, fq * 8);
#define PG8_SA(b, h) (((b) * 2 + (h)) * HTB)
#define PG8_SB(b, h) ((4 + (b) * 2 + (h)) * HTB)
#define PG8_STAGE(bufoff, gbase, voff) do { _Pragma("unroll") for (int _i = 0; _i < 2; ++_i) \
        __builtin_amdgcn_global_load_lds((const unsigned*)((const char*)(gbase) + (voff)[_i]), (LAS unsigned*)(lds + (bufoff) + ldsw + _i * 8192), 16, 0, 0); } while (0)
#define PG8_LDA(dst, b, h) do { _Pragma("unroll") for (int m = 0; m < 4; ++m) _Pragma("unroll") for (int k = 0; k < 2; ++k) dst[m][k] = *(const LAS bf16x8*)(lds + PG8_SA(b, h) + aoff + m * 2048 + k * 1024); } while (0)
#define PG8_LDB(dst, b, h) do { _Pragma("unroll") for (int n = 0; n < 2; ++n) _Pragma("unroll") for (int k = 0; k < 2; ++k) dst[n][k] = *(const LAS bf16x8*)(lds + PG8_SB(b, h) + boff + n * 2048 + k * 1024); } while (0)
#define PG8_MMA(ai, bj, At, Bt) do { __builtin_amdgcn_s_setprio(1); _Pragma("unroll") for (int m = 0; m < 4; ++m) _Pragma("unroll") for (int n = 0; n < 2; ++n) _Pragma("unroll") for (int k = 0; k < 2; ++k) \
        acc[ai][bj][m][n] = __builtin_amdgcn_mfma_f32_16x16x32_bf16(Bt[n][k], At[m][k], acc[ai][bj][m][n], 0, 0, 0); __builtin_amdgcn_s_setprio(0); } while (0)
#define PG8_WAIT_V(n) asm volatile("s_waitcnt vmcnt(" #n ")" ::: "memory")
#define PG8_WAIT_L(n) asm volatile("s_waitcnt lgkmcnt(" #n ")" ::: "memory")
#define PG8_BAR __builtin_amdgcn_s_barrier()
#define PG8_SCHED __builtin_amdgcn_sched_barrier(0)
    Unit cur, nxt; int ui = 0;
    if (!S.next(0, cur)) return;
    f32x4 acc[2][2][4][2];
#pragma unroll
    for (int a = 0; a < 2; ++a)
#pragma unroll
        for (int b = 0; b < 2; ++b)
#pragma unroll
            for (int m = 0; m < 4; ++m)
#pragma unroll
                for (int n = 0; n < 2; ++n) acc[a][b][m][n] = (f32x4){0.f, 0.f, 0.f, 0.f};
    bf16x8 At[4][2], B0[2][2], B1[2][2];
    const char* cA = (const char*)g.A + (size_t)cur.pm * tstep; const char* cB = (const char*)g.Bt + (size_t)cur.pn * tstep;
    S.a_ready(cur);
    PG8_STAGE(PG8_SB(0, 0), cB, voffB); PG8_STAGE(PG8_SA(0, 0), cA, voffA); PG8_STAGE(PG8_SB(0, 1), cB + hstep, voffB); PG8_STAGE(PG8_SA(0, 1), cA + hstep, voffA);
    if (wr == 1) PG8_BAR;
    PG8_WAIT_V(4); PG8_BAR;
    PG8_STAGE(PG8_SB(1, 0), cB + kstep, voffB); PG8_STAGE(PG8_SA(1, 0), cA + kstep, voffA); PG8_STAGE(PG8_SB(1, 1), cB + hstep + kstep, voffB);
    PG8_WAIT_V(6); PG8_BAR;
    for (;;) {
        const bool has_next = S.next(ui + 1, nxt);
        const char* nA = has_next ? (const char*)g.A + (size_t)nxt.pm * tstep : cA; const char* nB = has_next ? (const char*)g.Bt + (size_t)nxt.pn * tstep : cB;
        for (int t = 0; t < nt; t += 2) {
            const bool last = (t == nt - 2);
            const char* a1 = cA + (size_t)(t + 1) * kstep;
            const char* a2 = last ? nA : cA + (size_t)(t + 2) * kstep; const char* b2 = last ? nB : cB + (size_t)(t + 2) * kstep;
            const char* a3 = a2 + kstep; const char* b3 = b2 + kstep;
            if (last && has_next) S.a_ready(nxt);
            PG8_LDB(B0, 0, 0); PG8_SCHED; PG8_LDA(At, 0, 0); PG8_STAGE(PG8_SA(1, 1), a1 + hstep, voffA);
            PG8_WAIT_L(8); PG8_BAR; PG8_WAIT_L(0); PG8_MMA(0, 0, At, B0); PG8_BAR; PG8_SCHED;
            PG8_LDB(B1, 0, 1); PG8_STAGE(PG8_SB(0, 0), b2, voffB);
            PG8_BAR; PG8_WAIT_L(0); PG8_MMA(0, 1, At, B1); PG8_BAR;
            PG8_LDA(At, 0, 1); PG8_STAGE(PG8_SA(0, 0), a2, voffA);
            PG8_BAR; PG8_WAIT_L(0); PG8_MMA(1, 0, At, B0); PG8_BAR; PG8_SCHED;
            PG8_STAGE(PG8_SB(0, 1), b2 + hstep, voffB);
            PG8_WAIT_V(6); PG8_BAR; PG8_MMA(1, 1, At, B1); PG8_BAR;
            PG8_LDB(B0, 1, 0); PG8_SCHED; PG8_LDA(At, 1, 0); PG8_STAGE(PG8_SA(0, 1), a2 + hstep, voffA);
            PG8_WAIT_L(8); PG8_BAR; PG8_WAIT_L(0); PG8_MMA(0, 0, At, B0); PG8_BAR; PG8_SCHED;
            PG8_LDB(B1, 1, 1); PG8_STAGE(PG8_SB(1, 0), b3, voffB);
            PG8_BAR; PG8_WAIT_L(0); PG8_MMA(0, 1, At, B1); PG8_BAR;
            PG8_LDA(At, 1, 1); PG8_STAGE(PG8_SA(1, 0), a3, voffA);
            PG8_BAR; PG8_WAIT_L(0); PG8_MMA(1, 0, At, B0); PG8_BAR; PG8_SCHED;
            PG8_STAGE(PG8_SB(1, 1), b3 + hstep, voffB);
            PG8_WAIT_V(6); PG8_BAR; PG8_MMA(1, 1, At, B1); PG8_BAR;
        }
        E(acc, cur, wr, wc, fr, fq); S.done(cur);
        if (!has_next) break;
#pragma unroll
        for (int a = 0; a < 2; ++a)
#pragma unroll
            for (int b = 0; b < 2; ++b)
#pragma unroll
                for (int m = 0; m < 4; ++m)
#pragma unroll
                    for (int n = 0; n < 2; ++n) acc[a][b][m][n] = (f32x4){0.f, 0.f, 0.f, 0.f};
        cur = nxt; cA = nA; cB = nB; ++ui;
    }
    PG8_WAIT_V(0);
    if (wr == 0) PG8_BAR;
    PG8_BAR;
#undef PG8_SA
#undef PG8_SB
#undef PG8_STAGE
#undef PG8_LDA
#undef PG8_LDB
#undef PG8_MMA
#undef PG8_WAIT_V
#undef PG8_WAIT_L
#undef PG8_BAR
#undef PG8_SCHED
}
}

struct EpiSwiGLU {
    static constexpr bool PERM = true;
    bf16_t* H;
    __device__ __forceinline__ void operator()(const f32x4 (&acc)[2][2][4][2], const pg8::Unit& u, int wr, int wc, int fr, int fq) const {
        const int row0 = u.pm * 256 + wr * 64 + fr, col0 = u.pn * 128 + wc * 32 + 8 * fq;
#pragma unroll
        for (int ai = 0; ai < 2; ++ai)
#pragma unroll
            for (int m = 0; m < 4; ++m) {
                bf16_t* rowp = H + (size_t)(row0 + ai * 128 + m * 16) * DFF + col0;
                float h[8];
#pragma unroll
                for (int n = 0; n < 2; ++n)
#pragma unroll
                    for (int j = 0; j < 4; ++j) { const float gt = acc[ai][0][m][n][j], up = acc[ai][1][m][n][j]; h[n * 4 + j] = siluf_(gt) * up; }
                u32x4 w; w.x = cvt_pk_bf16(h[0], h[1]); w.y = cvt_pk_bf16(h[2], h[3]); w.z = cvt_pk_bf16(h[4], h[5]); w.w = cvt_pk_bf16(h[6], h[7]);
                *(u32x4*)rowp = w;
            }
    }
};
struct EpiBf16 {
    static constexpr bool PERM = true;
    bf16_t* O; int ldl; bf16_t* OC; int ldc;
    __device__ __forceinline__ void operator()(const f32x4 (&acc)[2][2][4][2], const pg8::Unit& u, int wr, int wc, int fr, int fq) const {
        const bool isc = u.pm >= 128;
        bf16_t* base = isc ? OC : O; const int ld = isc ? ldc : ldl;
        const int row0 = (isc ? (u.pm - 128) : u.pm) * 256 + wr * 64 + fr, col0 = u.pn * 256 + wc * 32 + 8 * fq;
#pragma unroll
        for (int ai = 0; ai < 2; ++ai)
#pragma unroll
            for (int m = 0; m < 4; ++m) {
                bf16_t* rowp = base + (size_t)(row0 + ai * 128 + m * 16) * ld + col0;
#pragma unroll
                for (int bj = 0; bj < 2; ++bj) {
                    const f32x4 v0 = acc[ai][bj][m][0], v1 = acc[ai][bj][m][1];
                    u32x4 w; w.x = cvt_pk_bf16(v0[0], v0[1]); w.y = cvt_pk_bf16(v0[2], v0[3]); w.z = cvt_pk_bf16(v1[0], v1[1]); w.w = cvt_pk_bf16(v1[2], v1[3]);
                    *(u32x4*)(rowp + bj * 128) = w;
                }
            }
    }
};
struct EpiRes {
    static constexpr bool PERM = false;
    const float* srcL; float* dstL; const float* srcC; float* dstC; const float* gate; float coef; int frow = -1;
    __device__ __forceinline__ void operator()(const f32x4 (&acc)[2][2][4][2], const pg8::Unit& u, int wr, int wc, int fr, int fq) const {
        const bool isc = u.pm >= 128;
        const float* src = isc ? srcC : srcL; float* dst = isc ? dstC : dstL;
        const int modrow = (frow >= 0) ? frow : (isc ? 8 : (u.pm >> 4));
        const int row0 = (isc ? (u.pm - 128) : u.pm) * 256 + wr * 64 + fr, col0 = u.pn * 256 + wc * 32 + 4 * fq;
        const float* gp = gate + (size_t)modrow * MODC + col0;
        f32x4 gv[2][2];
#pragma unroll
        for (int bj = 0; bj < 2; ++bj)
#pragma unroll
            for (int n = 0; n < 2; ++n) gv[bj][n] = *(const f32x4*)(gp + bj * 128 + n * 16) * coef;
#pragma unroll
        for (int ai = 0; ai < 2; ++ai) {
            f32x4 sv[4][2][2];
#pragma unroll
            for (int m = 0; m < 4; ++m) {
                const size_t ro = (size_t)(row0 + ai * 128 + m * 16) * DM + col0;
#pragma unroll
                for (int bj = 0; bj < 2; ++bj)
#pragma unroll
                    for (int n = 0; n < 2; ++n) sv[m][bj][n] = *(const f32x4*)(src + ro + bj * 128 + n * 16);
            }
            asm volatile("" ::: "memory");
#pragma unroll
            for (int m = 0; m < 4; ++m) {
                const size_t ro = (size_t)(row0 + ai * 128 + m * 16) * DM + col0;
#pragma unroll
                for (int bj = 0; bj < 2; ++bj)
#pragma unroll
                    for (int n = 0; n < 2; ++n) *(f32x4*)(dst + ro + bj * 128 + n * 16) = sv[m][bj][n] + gv[bj][n] * acc[ai][bj][m][n];
            }
            asm volatile("" ::: "memory");
        }
    }
};


template <class Epi, class Sched>
__device__ __forceinline__ void gemm_simple(const pg8::Gemm g, const Sched& S, const Epi& E) {
    const int tid = tid_opaque(), wid = tid >> 6, lane = tid & 63, wr = wid >> 2, wc = wid & 3, fr = lane & 15, fq = lane >> 4;
    const int K = g.K;
    pg8::Unit u;
    for (int i = 0; S.next(i, u); ++i) {
        f32x4 acc[2][2][4][2];
#pragma unroll
        for (int a = 0; a < 2; ++a)
#pragma unroll
            for (int b = 0; b < 2; ++b)
#pragma unroll
                for (int m = 0; m < 4; ++m)
#pragma unroll
                    for (int n = 0; n < 2; ++n) acc[a][b][m][n] = (f32x4){0.f, 0.f, 0.f, 0.f};
        const bf16_t* Ab = g.A + (size_t)(u.pm * 256 + wr * 64 + fr) * K + fq * 8;
        const bf16_t* Bb0 = g.Bt + (size_t)(u.pn * 256 + wc * 32 + (Epi::PERM ? pg8::perm32(fr) : fr)) * K + fq * 8;
        const bf16_t* Bb1 = g.Bt + (size_t)(u.pn * 256 + wc * 32 + (Epi::PERM ? pg8::perm32(16 + fr) : 16 + fr)) * K + fq * 8;
#pragma unroll 1
        for (int k0 = 0; k0 < K; k0 += 32) {
            bf16x8 a[2][4], b[2][2];
#pragma unroll
            for (int ai = 0; ai < 2; ++ai)
#pragma unroll
                for (int m = 0; m < 4; ++m) a[ai][m] = *(const bf16x8*)(Ab + (size_t)(ai * 128 + m * 16) * K + k0);
#pragma unroll
            for (int bj = 0; bj < 2; ++bj) { b[bj][0] = *(const bf16x8*)(Bb0 + (size_t)(bj * 128) * K + k0); b[bj][1] = *(const bf16x8*)(Bb1 + (size_t)(bj * 128) * K + k0); }
#pragma unroll
            for (int ai = 0; ai < 2; ++ai)
#pragma unroll
                for (int bj = 0; bj < 2; ++bj)
#pragma unroll
                    for (int m = 0; m < 4; ++m)
#pragma unroll
                        for (int n = 0; n < 2; ++n) acc[ai][bj][m][n] = __builtin_amdgcn_mfma_f32_16x16x32_bf16(b[bj][n], a[ai][m], acc[ai][bj][m][n], 0, 0, 0);
        }
        E(acc, u, wr, wc, fr, fq);
    }
}
#define GEMM_RUN(phn, g, S, E) do { if (SIMPLE_GEMM & (1 << (phn))) gemm_simple(g, S, E); else pg8::gemm_phase(lds, g, S, E); } while (0)

__device__ __forceinline__ void tr_tile(const float* __restrict__ src, int N, bf16_t* __restrict__ dst, int K, int k0, int n0, int rs, int off, float* tile) {
    const int tid = tid_opaque();
    const int c4 = (tid & 15) * 4;
#pragma unroll
    for (int pss = 0; pss < 2; ++pss) {
        const int r = (tid >> 4) + 32 * pss;
        const float4 x = *(const float4*)(src + (size_t)(k0 + r) * N + n0 + c4);
        float* t = tile + r * 65 + c4; t[0] = x.x; t[1] = x.y; t[2] = x.z; t[3] = x.w;
    }
    __syncthreads();
    const int n = tid >> 3, kq = tid & 7;
    float e[8];
#pragma unroll
    for (int j = 0; j < 8; ++j) e[j] = tile[(kq * 8 + j) * 65 + n];
    const int nn = n0 + n, row = (nn >> 7) * rs + off + (nn & 127);
    u32x4 w; w.x = cvt_pk_bf16(e[0], e[1]); w.y = cvt_pk_bf16(e[2], e[3]); w.z = cvt_pk_bf16(e[4], e[5]); w.w = cvt_pk_bf16(e[6], e[7]);
    *(u32x4*)(dst + (size_t)row * K + k0 + kq * 8) = w;
    __syncthreads();
}

__device__ __forceinline__ void prep_tiles(const Params& p, unsigned char* shm, int t_begin, int t_end, int start, int stride) {
    float* tile = (float*)shm;
    for (int t = t_begin + start; t < t_end; t += stride) {
        int job, lt = t;
        if (lt < 2816) job = 0; else if ((lt -= 2816) < 2816) job = 1; else if ((lt -= 2816) < 2816) job = 2; else if ((lt -= 2816) < 4096) job = 3;
        else if ((lt -= 4096) < 1024) job = 4; else if ((lt -= 1024) < 2816) job = 5; else if ((lt -= 2816) < 2816) job = 6; else { lt -= 2816; job = 7; }
        const float* src; bf16_t* dst; int K, N, rs = 128, off = 0;
        switch (job) {
            case 0: src = p.in[I_F1W1]; dst = (bf16_t*)(p.ws + WS_W13A); K = DM; N = DFF; rs = 256; break;
            case 1: src = p.in[I_F1W3]; dst = (bf16_t*)(p.ws + WS_W13A); K = DM; N = DFF; rs = 256; off = 128; break;
            case 2: src = p.in[I_F1W2]; dst = (bf16_t*)(p.ws + WS_W2A); K = DFF; N = DM; break;
            case 3: src = p.in[I_WIN]; dst = (bf16_t*)(p.ws + WS_WIN); K = DM; N = INC; break;
            case 4: src = p.in[I_WOUT]; dst = (bf16_t*)(p.ws + WS_WOUT); K = DM; N = DM; break;
            case 5: src = p.in[I_F2W1]; dst = (bf16_t*)(p.ws + WS_W13B); K = DM; N = DFF; rs = 256; break;
            case 6: src = p.in[I_F2W3]; dst = (bf16_t*)(p.ws + WS_W13B); K = DM; N = DFF; rs = 256; off = 128; break;
            default: src = p.in[I_F2W2]; dst = (bf16_t*)(p.ws + WS_W2B); K = DFF; N = DM; break;
        }
        const int nkt = K >> 6;
        const int kt = lt % nkt, ntl = lt / nkt;
        tr_tile(src, N, dst, K, kt * 64, ntl * 64, rs, off, tile);
    }
}

__device__ __forceinline__ void phase_prep(const Params& p, unsigned char* shm, bool defer_ffn2) {
    const int tid = tid_opaque(), G = gridDim.x, bid = blockIdx.x;
    if (defer_ffn2) { prep_tiles(p, shm, 0, 8448, bid, G); prep_tiles(p, shm, 10496, 12544, bid, G); }
    else prep_tiles(p, shm, 0, 22016, bid, G);
    {
        float* s = (float*)shm;
        float* modp = (float*)(p.ws + WS_MODP);
        for (int it = bid; it < 288; it += G) {
            const int cgp = it % 36, ks = it / 36;
            __syncthreads();
            if (tid < 256) {
#pragma unroll
                for (int j = 0; j < 9; ++j) { const float cv = (j < 8) ? p.in[I_C][j * DM + ks * 256 + tid] : p.in[I_CCTX][ks * 256 + tid]; s[j * 256 + tid] = siluf_(cv); }
            }
            __syncthreads();
            const int col = cgp * 512 + tid;
            const float* wp = p.in[I_ADAW] + (size_t)(ks * 256) * MODC + col;
            float acc[9];
#pragma unroll
            for (int j = 0; j < 9; ++j) acc[j] = 0.f;
#pragma unroll 4
            for (int k = 0; k < 256; k += 4) {
                const float w0 = wp[(size_t)(k + 0) * MODC], w1 = wp[(size_t)(k + 1) * MODC], w2 = wp[(size_t)(k + 2) * MODC], w3 = wp[(size_t)(k + 3) * MODC];
#pragma unroll
                for (int j = 0; j < 9; ++j) { const float4 sv = *(const float4*)&s[j * 256 + k]; acc[j] += sv.x * w0 + sv.y * w1 + sv.z * w2 + sv.w * w3; }
            }
#pragma unroll
            for (int j = 0; j < 9; ++j) modp[((size_t)ks * 9 + j) * MODC + col] = acc[j];
        }
        __syncthreads();
    }
    {
        float* z = (float*)shm;
        float* h1 = z + 8 * 36;
        float* h2 = h1 + 8 * 64;
        float* hid3T = (float*)(p.ws + WS_HID3);
        const int lg = tid >> 6, unit = tid & 63;
        const float fr = p.in[I_FFREQ][unit];
        for (int it = bid; it < 512; it += G) {
            const int lag = it * 8 + lg;
            __syncthreads();
            if (unit < 33) {
                float val;
                if (unit == 0) val = (float)lag / 4095.0f;
                else {
                    const int i = (unit - 1) & 15;
                    const float fb = 1e-4f + (float)i * ((15.0f - 1e-4f) / 15.0f);
                    const float ang = (0.0015339807878856412f * (float)lag) * fb;
                    val = (unit <= 16) ? cos_rad(ang) : -sin_rad(ang);
                }
                z[lg * 36 + unit] = val;
            }
            __syncthreads();
            float a = p.in[I_FB1][unit];
#pragma unroll 3
            for (int i = 0; i < 33; ++i) a += z[lg * 36 + i] * p.in[I_FW1][i * 64 + unit];
            h1[lg * 64 + unit] = sin_rad(fr * a);
            __syncthreads();
            a = p.in[I_FB2][unit];
#pragma unroll 8
            for (int i = 0; i < 64; ++i) a += h1[lg * 64 + i] * p.in[I_FW2][i * 64 + unit];
            h2[lg * 64 + unit] = sin_rad(fr * a);
            __syncthreads();
            a = p.in[I_FB3][unit];
#pragma unroll 8
            for (int i = 0; i < 64; ++i) a += h2[lg * 64 + i] * p.in[I_FW3][i * 64 + unit];
            hid3T[unit * 4096 + lag] = sin_rad(fr * a);
        }
        __syncthreads();
    }
}

__device__ __forceinline__ void phase_modreduce(const Params& p) {
    const float* modp = (const float*)(p.ws + WS_MODP);
    float* mod = (float*)(p.ws + WS_MOD);
    for (int i = blockIdx.x * 512 + tid_opaque(); i < 9 * MODC; i += gridDim.x * 512) {
        const int col = i % MODC;
        float a = p.in[I_ADAB][col];
#pragma unroll
        for (int ks = 0; ks < 8; ++ks) a += modp[(size_t)ks * 9 * MODC + i];
        mod[i] = a;
    }
}

__device__ __forceinline__ void phase_norm(const Params& p, const float* srcL, const float* srcC, int r_begin, int r_end, const float* gw, int sidx, int blk, int nblk) {
    const int tid = tid_opaque(); const int lane = tid & 63, gwv = blk * 8 + (tid >> 6), nw = nblk * 8; const int nrows = r_end - r_begin;
    const float* mod = (const float*)(p.ws + WS_MOD);
    bf16_t* A = (bf16_t*)(p.ws + WS_ABUF);
    const int per = (nrows + nw - 1) / nw, r_lo = r_begin + gwv * per, r_hi = (r_lo + per < r_end) ? (r_lo + per) : r_end;
    float4 g[8], s0[8], s1[8];
#pragma unroll
    for (int i = 0; i < 8; ++i) g[i] = *(const float4*)(gw + (i * 64 + lane) * 4);
    int cur = -1;
    for (int r = r_lo; r < r_hi; ++r) {
        const float* src = (r < ML) ? srcL + (size_t)r * DM : srcC + (size_t)(r - ML) * DM;
        const int mrow = (r < ML) ? (r >> 12) : 8;
        float4 xv[8]; float ss = 0.f;
#pragma unroll
        for (int i = 0; i < 8; ++i) xv[i] = *(const float4*)(src + (i * 64 + lane) * 4);
        if (mrow != cur) {
            cur = mrow;
            const float* sh = mod + (size_t)mrow * MODC + sidx * DM; const float* sc = sh + DM;
#pragma unroll
            for (int i = 0; i < 8; ++i) { s0[i] = *(const float4*)(sh + (i * 64 + lane) * 4); s1[i] = *(const float4*)(sc + (i * 64 + lane) * 4); }
        }
#pragma unroll
        for (int i = 0; i < 8; ++i) ss += xv[i].x * xv[i].x + xv[i].y * xv[i].y + xv[i].z * xv[i].z + xv[i].w * xv[i].w;
        ss = wave_sum(ss);
        const float inv = rsqrtf(ss * (1.0f / DM) + 1e-6f);
        u32x2 wv[8];
#pragma unroll
        for (int i = 0; i < 8; ++i) {
            const float o0 = xv[i].x * inv * g[i].x * (1.f + s1[i].x) + s0[i].x, o1 = xv[i].y * inv * g[i].y * (1.f + s1[i].y) + s0[i].y;
            const float o2 = xv[i].z * inv * g[i].z * (1.f + s1[i].z) + s0[i].z, o3 = xv[i].w * inv * g[i].w * (1.f + s1[i].w) + s0[i].w;
            wv[i].x = cvt_pk_bf16(o0, o1); wv[i].y = cvt_pk_bf16(o2, o3);
        }
#pragma unroll
        for (int i = 0; i < 8; ++i) *(u32x2*)(A + (size_t)r * DM + (i * 64 + lane) * 4) = wv[i];
    }
}

__device__ __forceinline__ void phase_final_norm(const Params& p) {
    const int tid = tid_opaque(); const int lane = tid & 63, gwv = blockIdx.x * 8 + (tid >> 6), nw = gridDim.x * 8;
    const float* gw = p.in[I_FNORM];
    const int per = (ML + nw - 1) / nw, r_lo = gwv * per, r_hi = (r_lo + per < ML) ? (r_lo + per) : ML;
    float4 g[8];
#pragma unroll
    for (int i = 0; i < 8; ++i) g[i] = *(const float4*)(gw + (i * 64 + lane) * 4);
    for (int r = r_lo; r < r_hi; ++r) {
        float* row = p.out + (size_t)r * DM;
        float4 xv[8]; float ss = 0.f;
#pragma unroll
        for (int i = 0; i < 8; ++i) xv[i] = *(const float4*)(row + (i * 64 + lane) * 4);
#pragma unroll
        for (int i = 0; i < 8; ++i) ss += xv[i].x * xv[i].x + xv[i].y * xv[i].y + xv[i].z * xv[i].z + xv[i].w * xv[i].w;
        ss = wave_sum(ss);
        const float inv = rsqrtf(ss * (1.0f / DM) + 1e-6f);
#pragma unroll
        for (int i = 0; i < 8; ++i)
            *(float4*)(row + (i * 64 + lane) * 4) = make_float4(xv[i].x * inv * g[i].x, xv[i].y * inv * g[i].y, xv[i].z * inv * g[i].z, xv[i].w * inv * g[i].w);
    }
}

__device__ __forceinline__ void phase_shortconv(const Params& p, unsigned char* shm, int t_start, int t_stride) {
    const int tid = tid_opaque();
    float* tile = (float*)shm;
    const bf16_t* PX = (const bf16_t*)(p.ws + WS_C);
    bf16_t* UT = (bf16_t*)(p.ws + WS_F);
    for (int t = t_start; t < NB * 64 * 12; t += t_stride) {
        const int cg4 = t % 12, gr = (t / 12) & 63, b = t / (12 * 64);
        {
            const int tt = tid >> 3, c8 = (tid & 7) * 8;
            u32x4 w[4];
#pragma unroll
            for (int q = 0; q < 4; ++q) w[q] = *(const u32x4*)(PX + (size_t)(b * SEQ + gr * 64 + tt) * INC + 5120 + (cg4 * 4 + q) * 64 + c8);
#pragma unroll
            for (int q = 0; q < 4; ++q) {
                float* tp = tile + q * (64 * 65) + tt * 65 + c8;
                tp[0] = bf_lo(w[q].x); tp[1] = bf_hi(w[q].x); tp[2] = bf_lo(w[q].y); tp[3] = bf_hi(w[q].y); tp[4] = bf_lo(w[q].z); tp[5] = bf_hi(w[q].z); tp[6] = bf_lo(w[q].w); tp[7] = bf_hi(w[q].w);
            }
        }
        __syncthreads();
#pragma unroll
        for (int q = 0; q < 4; ++q) {
            const int cc = tid >> 3, t8 = (tid & 7) * 8, ch = (cg4 * 4 + q) * 64 + cc;
            const float* tq = tile + q * (64 * 65);
            const float w0 = p.in[I_HCW][ch], w1 = p.in[I_HCW][3072 + ch], w2 = p.in[I_HCW][6144 + ch], bb = p.in[I_HCB][ch];
            float u[10];
#pragma unroll
            for (int j = 0; j < 10; ++j) { const int tt = t8 - 1 + j; u[j] = (tt >= 0 && tt < 64) ? tq[tt * 65 + cc] : 0.f; }
            float o[8];
#pragma unroll
            for (int j = 0; j < 8; ++j) o[j] = u[j] * w0 + u[j + 1] * w1 + u[j + 2] * w2 + bb;
            u32x4 w; w.x = cvt_pk_bf16(o[0], o[1]); w.y = cvt_pk_bf16(o[2], o[3]); w.z = cvt_pk_bf16(o[4], o[5]); w.w = cvt_pk_bf16(o[6], o[7]);
            *(u32x4*)(UT + ((size_t)(b * 3072 + ch)) * SEQ + gr * 64 + t8) = w;
        }
        __syncthreads();
    }
}

__device__ __forceinline__ int hg_row(int c, int s, int dir, int b) {
    if (c < 8) { const int q = c * 32 + s; return b * CTXL + (dir ? (CTXL - 1 - q) : q); }
    const int q = (c - 8) * 32 + s; return b * SEQ + (dir ? (SEQ - 1 - q) : q);
}
__device__ __forceinline__ void hgrn_item(const Params& p, int item, unsigned char* shm) {
    const int tid = tid_opaque(), w = tid >> 6, lane = tid & 63;
    const int dir = item & 1, vh = (item >> 1) & 1, h = (item >> 2) & 7, b = item >> 5;
    float* F = (float*)shm;
    float* Q = F + 32 * 128;
    float* V = Q + 32 * 128;
    float* OP = V + 32 * 64;
    const bf16_t* PX = (const bf16_t*)(p.ws + WS_C);
    const bf16_t* PXC = (const bf16_t*)(p.ws + WS_PXC);
    bf16_t* MIX = (bf16_t*)(p.ws + WS_ABUF);
    const int ls = tid >> 4, lk = (tid & 15) * 8;
    const int vs = (tid >> 3) & 31, v8 = (tid & 7) * 8;
    float lbv[8];
#pragma unroll
    for (int i = 0; i < 8; ++i) { const int j = h * 128 + lk + i; lbv[i] = sigmoidf_(p.in[I_LB][dir * 2048 + j] - p.in[I_LB][dir * 2048 + 1024 + j]); }
    f32x4 S4[4];
#pragma unroll
    for (int i = 0; i < 4; ++i) S4[i] = (f32x4){0.f, 0.f, 0.f, 0.f};
    const int vg4 = (lane >> 2) * 4, kq4 = (lane & 3) * 4;
    u32x4 rf, rq, rv;
    rq = (u32x4){0u, 0u, 0u, 0u}; rv = rq;
#if SKIP_CTX
    {
        const size_t ro = (size_t)hg_row(8, ls, dir, b) * INC;
        rf = *(const u32x4*)(PX + ro + dir * 1024 + h * 128 + lk);
        rq = *(const u32x4*)(PX + ro + 3072 + h * 128 + lk);
        if (tid < 256) rv = *(const u32x4*)(PX + (size_t)hg_row(8, vs, dir, b) * INC + 2048 + h * 128 + vh * 64 + v8);
    }
    for (int c = 8; c < 136; ++c) {
#else
    {
        const size_t ro = (size_t)hg_row(0, ls, dir, b) * 3072;
        rf = *(const u32x4*)(PXC + ro + dir * 1024 + h * 128 + lk);
        if (tid < 256) rv = *(const u32x4*)(PXC + (size_t)hg_row(0, vs, dir, b) * 3072 + 2048 + h * 128 + vh * 64 + v8);
    }
    for (int c = 0; c < 136; ++c) {
#endif
        const bool lat = c >= 8;
        __syncthreads();
        {
            float* fp = F + ls * 128 + lk;
            const float a0 = bf_lo(rf.x), a1 = bf_hi(rf.x), a2 = bf_lo(rf.y), a3 = bf_hi(rf.y), a4 = bf_lo(rf.z), a5 = bf_hi(rf.z), a6 = bf_lo(rf.w), a7 = bf_hi(rf.w);
            *(float4*)fp = make_float4(lbv[0] + (1.f - lbv[0]) * sigmoidf_(a0), lbv[1] + (1.f - lbv[1]) * sigmoidf_(a1), lbv[2] + (1.f - lbv[2]) * sigmoidf_(a2), lbv[3] + (1.f - lbv[3]) * sigmoidf_(a3));
            *(float4*)(fp + 4) = make_float4(lbv[4] + (1.f - lbv[4]) * sigmoidf_(a4), lbv[5] + (1.f - lbv[5]) * sigmoidf_(a5), lbv[6] + (1.f - lbv[6]) * sigmoidf_(a6), lbv[7] + (1.f - lbv[7]) * sigmoidf_(a7));
            if (lat) {
                const float qs = 0.08838834764831845f;
                float* qp = Q + ls * 128 + lk;
                *(float4*)qp = make_float4(bf_lo(rq.x) * qs, bf_hi(rq.x) * qs, bf_lo(rq.y) * qs, bf_hi(rq.y) * qs);
                *(float4*)(qp + 4) = make_float4(bf_lo(rq.z) * qs, bf_hi(rq.z) * qs, bf_lo(rq.w) * qs, bf_hi(rq.w) * qs);
            }
            if (tid < 256) {
                float* vp = V + vs * 64 + v8;
                *(float4*)vp = make_float4(bf_lo(rv.x), bf_hi(rv.x), bf_lo(rv.y), bf_hi(rv.y));
                *(float4*)(vp + 4) = make_float4(bf_lo(rv.z), bf_hi(rv.z), bf_lo(rv.w), bf_hi(rv.w));
            }
        }
        __syncthreads();
        if (c + 1 < 136) {
            const int cn = c + 1;
            if (cn < 8) {
                rf = *(const u32x4*)(PXC + (size_t)hg_row(cn, ls, dir, b) * 3072 + dir * 1024 + h * 128 + lk);
                if (tid < 256) rv = *(const u32x4*)(PXC + (size_t)hg_row(cn, vs, dir, b) * 3072 + 2048 + h * 128 + vh * 64 + v8);
            } else {
                const size_t ro = (size_t)hg_row(cn, ls, dir, b) * INC;
                rf = *(const u32x4*)(PX + ro + dir * 1024 + h * 128 + lk);
                rq = *(const u32x4*)(PX + ro + 3072 + h * 128 + lk);
                if (tid < 256) rv = *(const u32x4*)(PX + (size_t)hg_row(cn, vs, dir, b) * INC + 2048 + h * 128 + vh * 64 + v8);
            }
        }
        if (!lat) {
#pragma unroll 4
            for (int s = 0; s < 32; ++s) {
                const f32x4 v4 = *(const f32x4*)&V[s * 64 + vg4];
                const f32x4 f4 = *(const f32x4*)&F[s * 128 + w * 16 + kq4];
#pragma unroll
                for (int kk = 0; kk < 4; ++kk) {
                    const float fk = f4[kk];
                    const f32x4 t = v4 - fk * v4;
                    S4[kk] = fk * S4[kk] + t;
                }
            }
        } else {
#pragma unroll 4
            for (int s = 0; s < 32; ++s) {
                const f32x4 v4 = *(const f32x4*)&V[s * 64 + vg4];
                const f32x4 f4 = *(const f32x4*)&F[s * 128 + w * 16 + kq4];
                const f32x4 q4 = *(const f32x4*)&Q[s * 128 + w * 16 + kq4];
                f32x4 o = (f32x4){0.f, 0.f, 0.f, 0.f};
#pragma unroll
                for (int kk = 0; kk < 4; ++kk) {
                    const float fk = f4[kk];
                    const f32x4 t = v4 - fk * v4;
                    S4[kk] = fk * S4[kk] + t;
                    o += S4[kk] * q4[kk];
                }
#pragma unroll
                for (int j = 0; j < 4; ++j) {
                    float x = o[j];
                    x += __int_as_float(__builtin_amdgcn_update_dpp(0, __float_as_int(x), 0xB1, 0xf, 0xf, true));
                    x += __int_as_float(__builtin_amdgcn_update_dpp(0, __float_as_int(x), 0x4E, 0xf, 0xf, true));
                    o[j] = x;
                }
                if ((lane & 3) == 0) *(f32x4*)&OP[(w * 32 + s) * 64 + vg4] = o;
            }
            __syncthreads();
            {
                const int s = tid >> 4, v4 = (tid & 15) * 4;
                float4 a = *(const float4*)&OP[s * 64 + v4];
#pragma unroll
                for (int ww = 1; ww < 8; ++ww) { const float4 t = *(const float4*)&OP[(ww * 32 + s) * 64 + v4]; a.x += t.x; a.y += t.y; a.z += t.z; a.w += t.w; }
                u32x2 pk; pk.x = cvt_pk_bf16(a.x, a.y); pk.y = cvt_pk_bf16(a.z, a.w);
                *(u32x2*)(MIX + (size_t)hg_row(c, s, dir, b) * DM + dir * 1024 + h * 128 + vh * 64 + v4) = pk;
            }
        }
    }
    __syncthreads();
}


__device__ __forceinline__ int hg_row16(int c, int t, int dir, int b) {
    if (c < 16) { const int q = c * 16 + t; return b * CTXL + (dir ? (CTXL - 1 - q) : q); }
    const int q = (c - 16) * 16 + t; return b * SEQ + (dir ? (SEQ - 1 - q) : q);
}
__device__ __forceinline__ void hgrn_mfma_item(const Params& p, int item, unsigned char* shm) {
    const int tid = tid_opaque(), w = tid >> 6, lane = tid & 63, fr = lane & 15, fq = lane >> 4;
    const int dir = item & 1, h = (item >> 1) & 7, b = item >> 4;
    const bf16_t* PX = (const bf16_t*)(p.ws + WS_C);
    const bf16_t* PXC = (const bf16_t*)(p.ws + WS_PXC);
    bf16_t* MIX = (bf16_t*)(p.ws + WS_ABUF);
    const int kl = lane & 15, sq = lane >> 4, kcol = 16 * w + kl;
    const float lb = sigmoidf_(p.in[I_LB][dir * 2048 + h * 128 + kcol] - p.in[I_LB][dir * 2048 + 1024 + h * 128 + kcol]);
    f32x4 Sacc[8];
#pragma unroll
    for (int i = 0; i < 8; ++i) Sacc[i] = (f32x4){0.f, 0.f, 0.f, 0.f};
    bf16_t ra[4], rq[4], rv[4];
    const long sgn = dir ? -1 : 1;
    const bf16_t* pa[4]; const bf16_t* pv[4]; bf16_t* po[4];
#pragma unroll
    for (int j = 0; j < 4; ++j) {
        const long r0 = (long)b * CTXL + (dir ? CTXL - 1 : 0) + sgn * (4 * sq + j);
        pa[j] = PXC + r0 * 3072 + dir * 1024 + h * 128 + kcol; pv[j] = PXC + r0 * 3072 + 2048 + h * 128 + kcol;
        ra[j] = pa[j][0]; rv[j] = pv[j][0]; rq[j] = 0;
        po[j] = MIX + ((long)b * SEQ + (dir ? SEQ - 1 : 0) + sgn * (4 * fq + j)) * DM + dir * 1024 + h * 128 + 16 * w + fr;
    }
    for (int c = 0; c < 272; ++c) {
        const bool lat = c >= 16;
        unsigned char* sb = shm + (c & 1) * 36864;
        bf16_t* QT = (bf16_t*)(sb);
        bf16_t* KH = (bf16_t*)(sb + 4352);
        bf16_t* KTp = (bf16_t*)(sb + 8704);
        bf16_t* Vp = (bf16_t*)(sb + 13824);
        float* DEC = (float*)(sb + 18944);
        float kk[4], bt[4], qq[4], vv[4];
        {
            float run = 0.f;
#pragma unroll
            for (int j = 0; j < 4; ++j) {
                const float fj = lb + (1.f - lb) * sigmoidf_(bf2f(ra[j]));
                kk[j] = 1.f - fj; run += __logf(fj); bt[j] = run;
                qq[j] = bf2f(rq[j]) * 0.08838834764831845f; vv[j] = bf2f(rv[j]);
            }
            float x = run;
            const float y = __shfl_up(x, 16); if (sq >= 1) x += y;
            const float z = __shfl_up(x, 32); if (sq >= 2) x += z;
            const float excl = x - run;
            const float bend = __shfl(x, 48 + kl);
#pragma unroll
            for (int j = 0; j < 4; ++j) bt[j] += excl;
            if (c + 1 < 272) {
                const int cn = c + 1;
                if (cn == 16) {
#pragma unroll
                    for (int j = 0; j < 4; ++j) { const long r0 = (long)b * SEQ + (dir ? SEQ - 1 : 0) + sgn * (4 * sq + j);
                        pa[j] = PX + r0 * INC + dir * 1024 + h * 128 + kcol; pv[j] = PX + r0 * INC + 2048 + h * 128 + kcol; }
                } else {
                    const long st = sgn * 16 * (cn < 16 ? 3072 : INC);
#pragma unroll
                    for (int j = 0; j < 4; ++j) { pa[j] += st; pv[j] += st; }
                }
#pragma unroll
                for (int j = 0; j < 4; ++j) { ra[j] = pa[j][0]; rv[j] = pv[j][0]; if (cn >= 16) rq[j] = pv[j][1024]; }
            }
#pragma unroll
            for (int j = 0; j < 4; ++j) {
                const int st = 4 * sq + j;
                QT[st * 136 + kcol] = (bf16_t)(cvt_pk_safe(qq[j] * __expf(bt[j]), 0.f) & 0xffffu);
                KH[st * 136 + kcol] = (bf16_t)(cvt_pk_safe(kk[j] * __expf(-bt[j]), 0.f) & 0xffffu);
            }
            {
                u32x2 wk, wv;
                wk.x = cvt_pk_safe(kk[0] * __expf(bend - bt[0]), kk[1] * __expf(bend - bt[1])); wk.y = cvt_pk_safe(kk[2] * __expf(bend - bt[2]), kk[3] * __expf(bend - bt[3]));
                wv.x = cvt_pk_safe(vv[0], vv[1]); wv.y = cvt_pk_safe(vv[2], vv[3]);
                *(u32x2*)(KTp + kcol * 20 + 4 * sq) = wk;
                *(u32x2*)(Vp + kcol * 20 + 4 * sq) = wv;
            }
            if (sq == 3) DEC[kcol] = __expf(bend);
        }
        __syncthreads();
        u32x4 vbu; { const u32x2 t2 = *(const u32x2*)(Vp + (16 * w + fr) * 20 + 4 * fq); vbu.x = t2.x; vbu.y = t2.y; vbu.z = 0u; vbu.w = 0u; }
        const bf16x8 vb = __builtin_bit_cast(bf16x8, vbu);
        if (lat) {
            f32x4 at = (f32x4){0.f, 0.f, 0.f, 0.f};
#pragma unroll
            for (int ks = 0; ks < 4; ++ks) {
                const bf16x8 a = *(const bf16x8*)(KH + fr * 136 + ks * 32 + fq * 8);
                const bf16x8 bq = *(const bf16x8*)(QT + fr * 136 + ks * 32 + fq * 8);
                at = __builtin_amdgcn_mfma_f32_16x16x32_bf16(a, bq, at, 0, 0, 0);
            }
            asm volatile("s_nop 7\n\ts_nop 7" ::: "memory");
            u32x4 pau;
            {
                const float m0 = (4 * fq + 0 <= fr) ? at[0] : 0.f, m1 = (4 * fq + 1 <= fr) ? at[1] : 0.f, m2 = (4 * fq + 2 <= fr) ? at[2] : 0.f, m3 = (4 * fq + 3 <= fr) ? at[3] : 0.f;
                pau.x = cvt_pk_safe(m0, m1); pau.y = cvt_pk_safe(m2, m3); pau.z = 0u; pau.w = 0u;
            }
            f32x4 o = (f32x4){0.f, 0.f, 0.f, 0.f};
#pragma unroll
            for (int ks = 0; ks < 4; ++ks) {
                const u32x2 q0 = *(const u32x2*)(QT + fr * 136 + ks * 32 + 4 * fq), q1 = *(const u32x2*)(QT + fr * 136 + ks * 32 + 16 + 4 * fq);
                u32x4 au; au.x = q0.x; au.y = q0.y; au.z = q1.x; au.w = q1.y;
                u32x4 bu; bu.x = cvt_pk_safe(Sacc[2 * ks][0], Sacc[2 * ks][1]); bu.y = cvt_pk_safe(Sacc[2 * ks][2], Sacc[2 * ks][3]);
                bu.z = cvt_pk_safe(Sacc[2 * ks + 1][0], Sacc[2 * ks + 1][1]); bu.w = cvt_pk_safe(Sacc[2 * ks + 1][2], Sacc[2 * ks + 1][3]);
                o = __builtin_amdgcn_mfma_f32_16x16x32_bf16(__builtin_bit_cast(bf16x8, au), __builtin_bit_cast(bf16x8, bu), o, 0, 0, 0);
            }
            o = __builtin_amdgcn_mfma_f32_16x16x32_bf16(__builtin_bit_cast(bf16x8, pau), vb, o, 0, 0, 0);
#pragma unroll
            for (int r = 0; r < 4; ++r)
                { unsigned ub = __float_as_uint(o[r]); ub += 0x7fffu + ((ub >> 16) & 1u); po[r][0] = (bf16_t)(ub >> 16); po[r] += sgn * 16 * DM; }
        }
#pragma unroll
        for (int kt8 = 0; kt8 < 8; ++kt8) {
            const float4 d = *(const float4*)&DEC[16 * kt8 + 4 * fq];
            f32x4 sc = Sacc[kt8]; sc[0] *= d.x; sc[1] *= d.y; sc[2] *= d.z; sc[3] *= d.w;
            u32x4 au; { const u32x2 t2 = *(const u32x2*)(KTp + (16 * kt8 + fr) * 20 + 4 * fq); au.x = t2.x; au.y = t2.y; au.z = 0u; au.w = 0u; }
            Sacc[kt8] = __builtin_amdgcn_mfma_f32_16x16x32_bf16(__builtin_bit_cast(bf16x8, au), vb, sc, 0, 0, 0);
        }
    }
    __syncthreads();
}

__device__ __forceinline__ void hyena_item(const Params& p, int c, unsigned char* shm) {
    int tid = tid_opaque();
    float2* buf = (float2*)shm;
    float* wsm = (float*)(shm + FFT_LDS_ELEMS * 8);
    float* red = wsm + 256;
    bf16_t* UT = (bf16_t*)(p.ws + WS_F);
    const float* hid3T = (const float*)(p.ws + WS_HID3);
    __syncthreads();
    if (tid < 256) { const int j = tid >> 2, q = tid & 3; wsm[tid] = p.in[I_FWO][j * 4096 + q * 1024 + c]; }
    __syncthreads();
    const float dlo = -3.0701134573253945f, dhi = -15.350567286626972f;
    const float delta = fabsf(dlo + (float)c * ((dhi - dlo) / 1023.0f));
    float g0[16], g1[16];
    float l0 = 0.f, l1 = 0.f;
    {
        const float* hp[16];
#pragma unroll
        for (int m = 0; m < 16; ++m) {
            const int idx = tid + 512 * m;
            int lag = (m < 8) ? idx : (8192 - idx);
            lag = (lag < 4096) ? lag : 4095;
            hp[m] = hid3T + lag;
            g0[m] = 0.f; g1[m] = 0.f;
        }
#pragma unroll 4
        for (int j = 0; j < 64; ++j) {
            const float4 wv = *(const float4*)&wsm[j * 4];
#pragma unroll
            for (int m = 0; m < 16; ++m) {
                const float hv = hp[m][j * 4096];
                g0[m] += hv * ((m < 8) ? wv.x : wv.y);
                g1[m] += hv * ((m < 8) ? wv.z : wv.w);
            }
        }
#pragma unroll
        for (int m = 0; m < 16; ++m) {
            const int idx = tid + 512 * m;
            const int lag = (m < 8) ? idx : (8192 - idx);
            const float win = (lag < 4096) ? __expf(-((float)lag * (1.0f / 4095.0f)) * delta) : 0.f;
            g0[m] *= win; g1[m] *= win;
            l0 += fabsf(g0[m]); l1 += fabsf(g1[m]);
        }
    }
    l0 = wave_sum(l0); l1 = wave_sum(l1);
    if ((tid & 63) == 0) { red[(tid >> 6) * 2] = l0; red[(tid >> 6) * 2 + 1] = l1; }
    __syncthreads();
    l0 = 0.f; l1 = 0.f;
#pragma unroll
    for (int i = 0; i < 8; ++i) { l0 += red[i * 2]; l1 += red[i * 2 + 1]; }
    const float d0 = p.in[I_HYD][c], d1 = p.in[I_HYD][1024 + c];
#pragma unroll 1
    for (int f = 0; f < 2; ++f) {
        float2 v[16], H[16];
        const float sc = 1.0f / ((f ? l1 : l0) * 8192.0f);
#pragma unroll
        for (int m = 0; m < 16; ++m) v[m] = make_float2((f ? g1[m] : g0[m]) * sc, 0.f);
        FFT_FWD_TO_PAIRS(v, buf, tid);
#pragma unroll
        for (int m = 0; m < 16; ++m) H[m] = v[m];
        __syncthreads();
        const float dd = f ? d1 : d0;
#pragma unroll 1
        for (int pr = 0; pr < 4; ++pr) {
            asm volatile("" : "+v"(tid));
            const int b0 = 2 * pr, b1 = b0 + 1;
            bf16_t* s0 = UT + ((size_t)(b0 * 3072 + (f ? 1024 : 0) + c)) * SEQ;
            bf16_t* s1 = UT + ((size_t)(b1 * 3072 + (f ? 1024 : 0) + c)) * SEQ;
            float in0[8], in1[8];
#pragma unroll
            for (int m = 0; m < 8; ++m) { in0[m] = bf2f(s0[tid + 512 * m]); in1[m] = bf2f(s1[tid + 512 * m]); v[m] = make_float2(in0[m], in1[m]); v[m + 8] = make_float2(0.f, 0.f); }
            FFT_FWD_TO_PAIRS(v, buf, tid);
#pragma unroll
            for (int m = 0; m < 16; ++m) v[m] = cmul(v[m], H[m]);
            bf16_t* x0 = UT + ((size_t)(b0 * 3072 + (f ? 2048 : 1024) + c)) * SEQ;
            bf16_t* x1 = UT + ((size_t)(b1 * 3072 + (f ? 2048 : 1024) + c)) * SEQ;
            bf16_t* o0 = f ? UT + ((size_t)(b0 * 3072 + c)) * SEQ : x0;
            bf16_t* o1 = f ? UT + ((size_t)(b1 * 3072 + c)) * SEQ : x1;
            bf16_t xm0[8], xm1[8];
#pragma unroll
            for (int m = 0; m < 8; ++m) { xm0[m] = x0[tid + 512 * m]; xm1[m] = x1[tid + 512 * m]; }
            FFT_INV_FROM_PAIRS(v, buf, tid);
            bf16_t ro0[8], ro1[8];
#pragma unroll
            for (int m = 0; m < 8; ++m) {
                ro0[m] = f2bf(bf2f(xm0[m]) * (v[m].x + dd * in0[m]));
                ro1[m] = f2bf(bf2f(xm1[m]) * (v[m].y + dd * in1[m]));
            }
#pragma unroll
            for (int m = 0; m < 8; ++m) { o0[tid + 512 * m] = ro0[m]; o1[tid + 512 * m] = ro1[m]; }
        }
    }
    __syncthreads();
}

__device__ __forceinline__ void phase_readout(const Params& p) {
    const int tid = tid_opaque(); const int lane = tid & 63, gwv = blockIdx.x * 8 + (tid >> 6), nw = gridDim.x * 8;
    bf16_t* MIX = (bf16_t*)(p.ws + WS_ABUF);
    const bf16_t* PX = (const bf16_t*)(p.ws + WS_C);
    const int col = (lane >> 3) * 128 + (lane & 7) * 16;
    for (int r = gwv; r < ML; r += nw) {
        bf16_t* mp = MIX + (size_t)r * DM + col;
        const bf16_t* gp = PX + (size_t)r * INC + 4096 + col;
        float o[16], g[16];
#pragma unroll
        for (int hh = 0; hh < 2; ++hh) {
            const u32x4 a = *(const u32x4*)(mp + hh * 8), bq = *(const u32x4*)(mp + 1024 + hh * 8), gg = *(const u32x4*)(gp + hh * 8);
            o[hh * 8 + 0] = bf_lo(a.x) + bf_lo(bq.x); o[hh * 8 + 1] = bf_hi(a.x) + bf_hi(bq.x); o[hh * 8 + 2] = bf_lo(a.y) + bf_lo(bq.y); o[hh * 8 + 3] = bf_hi(a.y) + bf_hi(bq.y);
            o[hh * 8 + 4] = bf_lo(a.z) + bf_lo(bq.z); o[hh * 8 + 5] = bf_hi(a.z) + bf_hi(bq.z); o[hh * 8 + 6] = bf_lo(a.w) + bf_lo(bq.w); o[hh * 8 + 7] = bf_hi(a.w) + bf_hi(bq.w);
            g[hh * 8 + 0] = bf_lo(gg.x); g[hh * 8 + 1] = bf_hi(gg.x); g[hh * 8 + 2] = bf_lo(gg.y); g[hh * 8 + 3] = bf_hi(gg.y);
            g[hh * 8 + 4] = bf_lo(gg.z); g[hh * 8 + 5] = bf_hi(gg.z); g[hh * 8 + 6] = bf_lo(gg.w); g[hh * 8 + 7] = bf_hi(gg.w);
        }
        float ss = 0.f;
#pragma unroll
        for (int i = 0; i < 16; ++i) ss += o[i] * o[i];
        ss += __shfl_xor(ss, 1); ss += __shfl_xor(ss, 2); ss += __shfl_xor(ss, 4);
        const float inv = rsqrtf(ss * (1.0f / 128.0f) + 1e-6f);
        float res[16];
#pragma unroll
        for (int i = 0; i < 16; ++i) res[i] = HG_SCALE * o[i] * inv * p.in[I_HGN][col + i] * siluf_(g[i]);
#pragma unroll
        for (int hh = 0; hh < 2; ++hh) {
            u32x4 w; w.x = cvt_pk_bf16(res[hh * 8 + 0], res[hh * 8 + 1]); w.y = cvt_pk_bf16(res[hh * 8 + 2], res[hh * 8 + 3]); w.z = cvt_pk_bf16(res[hh * 8 + 4], res[hh * 8 + 5]); w.w = cvt_pk_bf16(res[hh * 8 + 6], res[hh * 8 + 7]);
            *(u32x4*)(mp + hh * 8) = w;
        }
    }
}

__device__ __forceinline__ void phase_ytrans(const Params& p, unsigned char* shm) {
    const int tid = tid_opaque();
    float* tile = (float*)shm;
    const bf16_t* UT = (const bf16_t*)(p.ws + WS_F);
    bf16_t* MIX = (bf16_t*)(p.ws + WS_ABUF);
    for (int t = blockIdx.x; t < NB * 64 * 4; t += gridDim.x) {
        const int cg4 = t & 3, tb = (t >> 2) & 63, b = t >> 8;
        {
            const int cc = tid >> 3, t8 = (tid & 7) * 8;
            u32x4 w[4];
#pragma unroll
            for (int q = 0; q < 4; ++q) w[q] = *(const u32x4*)(UT + ((size_t)(b * 3072 + (cg4 * 4 + q) * 64 + cc)) * SEQ + tb * 64 + t8);
#pragma unroll
            for (int q = 0; q < 4; ++q) {
                float* tp = tile + q * (64 * 65) + cc * 65 + t8;
                tp[0] = bf_lo(w[q].x); tp[1] = bf_hi(w[q].x); tp[2] = bf_lo(w[q].y); tp[3] = bf_hi(w[q].y); tp[4] = bf_lo(w[q].z); tp[5] = bf_hi(w[q].z); tp[6] = bf_lo(w[q].w); tp[7] = bf_hi(w[q].w);
            }
        }
        __syncthreads();
#pragma unroll
        for (int q = 0; q < 4; ++q) {
            const int tt = tid >> 3, c8 = (tid & 7) * 8;
            const float* tq = tile + q * (64 * 65);
            float e[8];
#pragma unroll
            for (int j = 0; j < 8; ++j) e[j] = tq[(c8 + j) * 65 + tt];
            u32x4 w; w.x = cvt_pk_bf16(e[0], e[1]); w.y = cvt_pk_bf16(e[2], e[3]); w.z = cvt_pk_bf16(e[4], e[5]); w.w = cvt_pk_bf16(e[6], e[7]);
            *(u32x4*)(MIX + (size_t)(b * SEQ + tb * 64 + tt) * DM + 1024 + (cg4 * 4 + q) * 64 + c8) = w;
        }
        __syncthreads();
    }
}


#if DEBUG_CHECK
constexpr size_t WS_DBG = WS_END;
__device__ __forceinline__ float rbf(float x) { return bf2f(f2bf(x)); }
__device__ __forceinline__ void dbg_max(const Params& p, int slot, float e) { atomicMax((unsigned*)(p.ws + WS_DBG) + slot, __float_as_uint(e)); }
__device__ __forceinline__ unsigned hsh(unsigned x) { x ^= x >> 16; x *= 0x7feb352du; x ^= x >> 15; x *= 0x846ca68bu; x ^= x >> 16; return x; }
__device__ __forceinline__ float relerr(float got, float ref, float abs_floor) { return fabsf(got - ref) / (fabsf(ref) + abs_floor); }
__device__ __forceinline__ float naive_norm_elem(const float* src, const float* gw, const float* modrow, int sidx, int col) {
    float ss = 0.f; for (int k = 0; k < DM; ++k) ss += src[k] * src[k];
    const float inv = rsqrtf(ss / DM + 1e-6f);
    return src[col] * inv * gw[col] * (1.f + modrow[(sidx + 1) * DM + col]) + modrow[sidx * DM + col];
}
__device__ __forceinline__ void gemm_checks(const Params& p, int which) {
    const unsigned sid = blockIdx.x * 512 + threadIdx.x;
    const unsigned h1 = hsh(sid * 2u + 1u), h2 = hsh(sid * 2u + 2u);
    const float* mod = (const float*)(p.ws + WS_MOD);
    const bf16_t* ABUF = (const bf16_t*)(p.ws + WS_ABUF);
    const bf16_t* CB = (const bf16_t*)(p.ws + WS_C);
    const float* X1C = (const float*)(p.ws + WS_X1C);
    if (which == 1) {
        const int j = h1 % 9, col = h2 % MODC;
        float a = p.in[I_ADAB][col];
        for (int k = 0; k < DM; ++k) { const float cv = (j < 8) ? p.in[I_C][j * DM + k] : p.in[I_CCTX][k]; a += (cv / (1.f + expf(-cv))) * p.in[I_ADAW][(size_t)k * MODC + col]; }
        dbg_max(p, 0, relerr(mod[(size_t)j * MODC + col], a, 0.02f));
    } else if (which == 2 || which == 5 || which == 11) {
        const int nrows = (which == 11) ? ML : MT;
        const int row = h1 % nrows, col = h2 % DM;
        const float* src; const float* gw; int sidx;
        if (which == 2) { src = (row < ML) ? p.in[I_X] + (size_t)row * DM : p.in[I_CTX] + (size_t)(row - ML) * DM; gw = p.in[I_NFFN1]; sidx = 0; }
        else if (which == 5) { src = (row < ML) ? p.out + (size_t)row * DM : X1C + (size_t)(row - ML) * DM; gw = p.in[I_NMIX]; sidx = 3; }
        else { src = p.out + (size_t)row * DM; gw = p.in[I_NFFN2]; sidx = 6; }
        const float* modrow = mod + (size_t)((row < ML) ? (row >> 12) : 8) * MODC;
        const float ref = naive_norm_elem(src, gw, modrow, sidx, col);
        dbg_max(p, (which == 2) ? 1 : (which == 5) ? 4 : 7, relerr(bf2f(ABUF[(size_t)row * DM + col]), ref, 0.05f));
    } else if (which == 3 || which == 12) {
        const int nrows = (which == 12) ? ML : MT;
        const int row = h1 % nrows, hc = h2 % DFF;
        const float* w1 = p.in[(which == 3) ? I_F1W1 : I_F2W1]; const float* w3 = p.in[(which == 3) ? I_F1W3 : I_F2W3];
        float g = 0.f, u = 0.f;
        for (int k = 0; k < DM; ++k) { const float a = bf2f(ABUF[(size_t)row * DM + k]); g += a * rbf(w1[(size_t)k * DFF + hc]); u += a * rbf(w3[(size_t)k * DFF + hc]); }
        const float ref = (g / (1.f + expf(-g))) * u;
        dbg_max(p, (which == 3) ? 2 : 8, relerr(bf2f(CB[(size_t)row * DFF + hc]), ref, 0.05f));
    } else if (which == 4) {
        const int row = h1 % MT, col = h2 % DM;
        float d = 0.f;
        for (int k = 0; k < DFF; ++k) d += bf2f(CB[(size_t)row * DFF + k]) * rbf(p.in[I_F1W2][(size_t)k * DM + col]);
        const float src = (row < ML) ? p.in[I_X][(size_t)row * DM + col] : p.in[I_CTX][(size_t)(row - ML) * DM + col];
        const float gt = mod[(size_t)((row < ML) ? (row >> 12) : 8) * MODC + 2 * DM + col];
        const float ref = src + 0.5f * gt * d;
        const float got = (row < ML) ? p.out[(size_t)row * DM + col] : X1C[(size_t)(row - ML) * DM + col];
        dbg_max(p, 3, relerr(got, ref, 0.05f));
    } else if (which == 6) {
        const bool isc = (sid & 15) == 0;
        const int row = isc ? ML + (h1 % MC) : (h1 % ML), col = isc ? (h2 % 3072) : (h2 % INC);
        float d = 0.f;
        for (int k = 0; k < DM; ++k) d += bf2f(ABUF[(size_t)row * DM + k]) * rbf(p.in[I_WIN][(size_t)k * INC + col]);
        const float got = isc ? bf2f(((const bf16_t*)(p.ws + WS_PXC))[(size_t)(row - ML) * 3072 + col]) : bf2f(CB[(size_t)row * INC + col]);
        dbg_max(p, isc ? 6 : 5, relerr(got, d, 0.05f));
    }
}
#endif

#if ROWCHK
__device__ __forceinline__ float blk_max(float v, float* red) {
    const int tid = threadIdx.x;
    __syncthreads(); red[tid] = v; __syncthreads();
    float m = 0.f; for (int i = 0; i < 512; ++i) m = fmaxf(m, red[i]);
    __syncthreads();
    return m;
}
__device__ __forceinline__ float blk_sum(float v, float* red) {
    const int tid = threadIdx.x;
    __syncthreads(); red[tid] = v; __syncthreads();
    float m = 0.f; for (int i = 0; i < 512; ++i) m += red[i];
    __syncthreads();
    return m;
}
__device__ __forceinline__ void rc_norm(const float* src, const float* gw, const float* modb, int sidx, float* hrow, float* red) {
    const int tid = threadIdx.x;
    float ss = 0.f; for (int c = tid; c < DM; c += 512) ss += src[c] * src[c];
    __syncthreads(); red[tid] = ss; __syncthreads();
    float t = 0.f; for (int i = 0; i < 512; ++i) t += red[i];
    const float inv = 1.0f / sqrtf(t / DM + 1e-6f);
    for (int c = tid; c < DM; c += 512) hrow[c] = src[c] * inv * gw[c] * (1.f + modb[(sidx + 1) * DM + c]) + modb[sidx * DM + c];
    __syncthreads();
}
__device__ __forceinline__ void rc_ffn(const float* hrow, float* hid, const float* w1, const float* w3) {
    const int tid = threadIdx.x;
    for (int j = tid; j < DFF; j += 512) {
        float g = 0.f, u = 0.f;
        for (int k = 0; k < DM; ++k) { g += hrow[k] * w1[(size_t)k * DFF + j]; u += hrow[k] * w3[(size_t)k * DFF + j]; }
        hid[j] = (g / (1.f + expf(-g))) * u;
    }
    __syncthreads();
}
__device__ __forceinline__ void row_checks(const Params& p, int which, unsigned char* shm) {
    float* hrow = (float*)shm; float* hid = hrow + 2048; float* red = hid + 5632;
    const int tid = threadIdx.x, bid = blockIdx.x;
    const int row = bid * 128 + ((bid * 37) & 127);
    const float* modb = (const float*)(p.ws + WS_MOD) + (size_t)(row >> 12) * MODC;
    float* dbg = (float*)(p.ws + WS_MODP);
    float* save = dbg + 4096 + (size_t)bid * 2048;
    float e = 0.f, r2 = 0.f;
    if (which == 0 && bid >= 999) {
        const int rc = (bid - 192) * 32 + 7;
        const float* modc = (const float*)(p.ws + WS_MOD) + (size_t)8 * MODC;
        const float* X1Cc = (const float*)(p.ws + WS_X1C);
        rc_norm(p.in[I_CTX] + (size_t)rc * DM, p.in[I_NFFN1], modc, 0, hrow, red);
        rc_ffn(hrow, hid, p.in[I_F1W1], p.in[I_F1W3]);
        for (int c = tid; c < DM; c += 512) { float d = 0.f; for (int j = 0; j < DFF; ++j) d += hid[j] * p.in[I_F1W2][(size_t)j * DM + c];
            const float ref = p.in[I_CTX][(size_t)rc * DM + c] + 0.5f * modc[2 * DM + c] * d; { const float df = X1Cc[(size_t)rc * DM + c] - ref; e += df * df; r2 += ref * ref; } }
        e = blk_sum(e, red); r2 = blk_sum(r2, red); if (tid == 0) { dbg[5 * 256 + bid] = e; dbg[2048 + 5 * 256 + bid] = r2; }
    } else if (which == 1 && bid >= 999) {
        const int rc = (bid - 192) * 32 + 7;
        const float* modc = (const float*)(p.ws + WS_MOD) + (size_t)8 * MODC;
        rc_norm((const float*)(p.ws + WS_X1C) + (size_t)rc * DM, p.in[I_NMIX], modc, 3, hrow, red);
        const bf16_t* PXCc = (const bf16_t*)(p.ws + WS_PXC);
        for (int c = tid; c < 3072; c += 512) { float d = 0.f; for (int k = 0; k < DM; ++k) d += hrow[k] * p.in[I_WIN][(size_t)k * INC + c];
            { const float df = bf2f(PXCc[(size_t)rc * 3072 + c]) - d; e += df * df; r2 += d * d; } }
        e = blk_sum(e, red); r2 = blk_sum(r2, red); if (tid == 0) { dbg[7 * 256 + bid] = e; dbg[2048 + 7 * 256 + bid] = r2; }
    } else if (which == 0) {
        rc_norm(p.in[I_X] + (size_t)row * DM, p.in[I_NFFN1], modb, 0, hrow, red);
        rc_ffn(hrow, hid, p.in[I_F1W1], p.in[I_F1W3]);
        for (int c = tid; c < DM; c += 512) { float d = 0.f; for (int j = 0; j < DFF; ++j) d += hid[j] * p.in[I_F1W2][(size_t)j * DM + c];
            const float ref = p.in[I_X][(size_t)row * DM + c] + 0.5f * modb[2 * DM + c] * d; { const float df = p.out[(size_t)row * DM + c] - ref; e += df * df; r2 += ref * ref; } }
        e = blk_sum(e, red); r2 = blk_sum(r2, red); if (tid == 0) { dbg[0 * 256 + bid] = e; dbg[2048 + 0 * 256 + bid] = r2; }
    } else if (which == 1) {
        rc_norm(p.out + (size_t)row * DM, p.in[I_NMIX], modb, 3, hrow, red);
        const bf16_t* PX = (const bf16_t*)(p.ws + WS_C);
        for (int c = tid; c < INC; c += 512) { float d = 0.f; for (int k = 0; k < DM; ++k) d += hrow[k] * p.in[I_WIN][(size_t)k * INC + c];
            { const float df = bf2f(PX[(size_t)row * INC + c]) - d; e += df * df; r2 += d * d; } }
        e = blk_sum(e, red); r2 = blk_sum(r2, red); if (tid == 0) { dbg[1 * 256 + bid] = e; dbg[2048 + 1 * 256 + bid] = r2; }
    } else if (which == 2) {
        const bf16_t* MIX = (const bf16_t*)(p.ws + WS_ABUF);
        for (int c = tid; c < DM; c += 512) { float d = 0.f; for (int k = 0; k < DM; ++k) d += bf2f(MIX[(size_t)row * DM + k]) * p.in[I_WOUT][(size_t)k * DM + c];
            save[c] = p.out[(size_t)row * DM + c] + modb[5 * DM + c] * d; }
    } else if (which == 3) {
        for (int c = tid; c < DM; c += 512) { const float df = p.out[(size_t)row * DM + c] - save[c]; e += df * df; r2 += save[c] * save[c]; }
        e = blk_sum(e, red); r2 = blk_sum(r2, red); if (tid == 0) { dbg[2 * 256 + bid] = e; dbg[2048 + 2 * 256 + bid] = r2; }
        rc_norm(p.out + (size_t)row * DM, p.in[I_NFFN2], modb, 6, hrow, red);
        rc_ffn(hrow, hid, p.in[I_F2W1], p.in[I_F2W3]);
        for (int c = tid; c < DM; c += 512) { float d = 0.f; for (int j = 0; j < DFF; ++j) d += hid[j] * p.in[I_F2W2][(size_t)j * DM + c];
            save[c] = p.out[(size_t)row * DM + c] + 0.5f * modb[8 * DM + c] * d; }
    } else if (which == 4) {
        for (int c = tid; c < DM; c += 512) { const float df = p.out[(size_t)row * DM + c] - save[c]; e += df * df; r2 += save[c] * save[c]; }
        e = blk_sum(e, red); r2 = blk_sum(r2, red); if (tid == 0) { dbg[3 * 256 + bid] = e; dbg[2048 + 3 * 256 + bid] = r2; }
        float ss = 0.f; for (int c = tid; c < DM; c += 512) ss += p.out[(size_t)row * DM + c] * p.out[(size_t)row * DM + c];
        __syncthreads(); red[tid] = ss; __syncthreads();
        float t = 0.f; for (int i = 0; i < 512; ++i) t += red[i];
        const float inv = 1.0f / sqrtf(t / DM + 1e-6f);
        for (int c = tid; c < DM; c += 512) save[c] = p.out[(size_t)row * DM + c] * inv * p.in[I_FNORM][c];
    } else if (which == 5) {
        for (int c = tid; c < DM; c += 512) { const float df = p.out[(size_t)row * DM + c] - save[c]; e += df * df; r2 += save[c] * save[c]; }
        e = blk_sum(e, red); r2 = blk_sum(r2, red); if (tid == 0) { dbg[4 * 256 + bid] = e; dbg[2048 + 4 * 256 + bid] = r2; }
    } else if (which == 10) {
        const bf16_t* PX = (const bf16_t*)(p.ws + WS_C); const bf16_t* PXC = (const bf16_t*)(p.ws + WS_PXC); const bf16_t* MIX = (const bf16_t*)(p.ws + WS_ABUF);
        float* SL = (float*)shm;
        float* lbs = SL + 128 * 64;
        const int b = bid & 7, h = (bid >> 3) & 7, dir = (bid >> 6) & 1, v = (bid >> 7) * 64 + (tid & 63);
        if (tid < 128) { const int j = h * 128 + tid; lbs[tid] = sigmoidf_(p.in[I_LB][dir * 2048 + j] - p.in[I_LB][dir * 2048 + 1024 + j]); }
        __syncthreads();
        if (tid < 64) {
            for (int k = 0; k < 128; ++k) SL[k * 64 + tid] = 0.f;
            for (int step = 0; step < CTXL + SEQ; ++step) {
                const bool lat = step >= CTXL;
                const int q = lat ? step - CTXL : step;
                const bf16_t* rowp; int rw;
                if (!lat) { rw = b * CTXL + (dir ? CTXL - 1 - q : q); rowp = PXC + (size_t)rw * 3072; }
                else { rw = b * SEQ + (dir ? SEQ - 1 - q : q); rowp = PX + (size_t)rw * INC; }
                const float vv = bf2f(rowp[2048 + h * 128 + v]);
                float o = 0.f;
#pragma unroll 4
                for (int k = 0; k < 128; ++k) {
                    const float f = lbs[k] + (1.f - lbs[k]) * sigmoidf_(bf2f(rowp[dir * 1024 + h * 128 + k]));
                    const float sn = f * SL[k * 64 + tid] + (1.f - f) * vv;
                    SL[k * 64 + tid] = sn;
                    if (lat) o += sn * bf2f(rowp[3072 + h * 128 + k]) * 0.08838834764831845f;
                }
                if (lat) { const float got = bf2f(MIX[(size_t)rw * DM + dir * 1024 + h * 128 + v]); const float df = got - o; e += df * df; r2 += o * o; }
            }
        }
        e = blk_sum(e, red + 8192); r2 = blk_sum(r2, red + 8192); if (tid == 0) { dbg[528384 + bid] = e; dbg[528640 + bid] = r2; }
    } else if (which == 8) {
        const bf16_t* MIX = (const bf16_t*)(p.ws + WS_ABUF); const bf16_t* PX = (const bf16_t*)(p.ws + WS_C);
        for (int c = tid; c < 1024; c += 512) hrow[c] = bf2f(MIX[(size_t)row * DM + c]) + bf2f(MIX[(size_t)row * DM + 1024 + c]);
        __syncthreads();
        for (int c = tid; c < 1024; c += 512) { const int h0 = c & ~127; float ss = 0.f; for (int k = 0; k < 128; ++k) ss += hrow[h0 + k] * hrow[h0 + k];
            const float g = bf2f(PX[(size_t)row * INC + 4096 + c]);
            save[c] = hrow[c] / sqrtf(ss / 128.f + 1e-6f) * p.in[I_HGN][c] * (g / (1.f + expf(-g))); }
    } else if (which == 9) {
        const bf16_t* MIX = (const bf16_t*)(p.ws + WS_ABUF);
        for (int c = tid; c < 1024; c += 512) { const float df = bf2f(MIX[(size_t)row * DM + c]) - save[c]; e += df * df; r2 += save[c] * save[c]; }
        e = blk_sum(e, red); r2 = blk_sum(r2, red); if (tid == 0) { dbg[6 * 256 + bid] = e; dbg[2048 + 6 * 256 + bid] = r2; }
    } else if (which == 6) {
        if (bid == 0 && tid == 0) { float code = 0.f; for (int i = 0; i < 8; ++i) { float se = 0.f, sr = 0.f; for (int j = 0; j < 256; ++j) { const bool use = (i != 5 && i != 7); if (use) { se += dbg[i * 256 + j]; sr += dbg[2048 + i * 256 + j]; } } if (se > ROWCHK_TOL * sr) code += (float)(1 << i); } { for (int j = 0; j < 256; ++j) if (false && dbg[528384 + j] / (dbg[528640 + j] + 1e-20f) > HGCHK_TOL) code += 1.f; } p.out[0] += 10.f * code; }
    }
}
#endif

__global__ __launch_bounds__(512, 2) void mega(Params p) {
    extern __shared__ __attribute__((aligned(16))) unsigned char shm[];
    cg::grid_group grid = cg::this_grid();
    const int G = gridDim.x, bid = blockIdx.x;
    LAS unsigned char* lds = (LAS unsigned char*)shm;
    float* mod = (float*)(p.ws + WS_MOD);
    bf16_t* ABUF = (bf16_t*)(p.ws + WS_ABUF);
    bf16_t* CB = (bf16_t*)(p.ws + WS_C);
    float* X1C = (float*)(p.ws + WS_X1C);
    const bool split_ctx = (G >= 128) && (p.ph_lo == 0) && (p.ph_hi == NPH);
#if ROWCHK
    if (p.ph_lo >= 300) { row_checks(p, p.ph_lo - 300, shm); return; }
#endif
#if DEBUG_CHECK
    if (p.ph_lo >= 100 && p.ph_lo < 200) { gemm_checks(p, p.ph_lo - 100); return; }
    if (p.ph_lo == 200) {
        if (blockIdx.x == 0 && threadIdx.x == 0) { const float* d = (const float*)(p.ws + WS_DBG); float code = 0.f; for (int i = 0; i < 9; ++i) if (d[i] > 0.03f) code += (float)(1 << i); p.out[0] += 10.f * code; }
        return;
    }
#endif
#if DEBUG_CHECK
        if (p.ph_lo == 0 && blockIdx.x == 0 && threadIdx.x < 16) ((unsigned*)(p.ws + WS_DBG))[threadIdx.x] = 0u;
#endif
    unsigned long long tacc = 0ull, tprev = TSEL ? wall_clock64() : 0ull;
        PHASE_BEGIN(0) phase_prep(p, shm, split_ctx);
        PHASE_BEGIN(1) phase_modreduce(p);
        PHASE_BEGIN(2) phase_norm(p, p.in[I_X], p.in[I_CTX], 0, MT, p.in[I_NFFN1], 0, bid, G);
        PHASE_BEGIN(3) {
            pg8::Gemm g{ABUF, (const bf16_t*)(p.ws + WS_W13A), MT, 2 * DFF, DM};
            pg8::StaticOrder S; S.init(g.M, g.N, G, bid, 0);
            EpiSwiGLU E{CB};
            GEMM_RUN(3, g, S, E);
            if (split_ctx && G == 256 && bid >= 96) prep_tiles(p, shm, 8448, 10496, bid - 96, G - 96);
            else if (split_ctx && G != 256) prep_tiles(p, shm, 8448, 10496, bid, G);
        } PHASE_BEGIN(4) {
            pg8::Gemm g{CB, (const bf16_t*)(p.ws + WS_W2A), split_ctx ? ML : MT, DM, DFF};
            pg8::StaticOrder S; S.init(g.M, g.N, G, bid, 0);
            EpiRes E{p.in[I_X], p.out, p.in[I_CTX], X1C, mod + 2 * DM, 0.5f};
            GEMM_RUN(4, g, S, E);
        } PHASE_BEGIN(5) {
            if (!split_ctx) phase_norm(p, p.out, X1C, 0, MT, p.in[I_NMIX], 3, bid, G);
            else if (bid < 64) {
                pg8::Gemm g{CB + (size_t)ML * DFF, (const bf16_t*)(p.ws + WS_W2A), MC, DM, DFF};
                pg8::StaticOrder S; S.init(g.M, g.N, 64, bid, 0);
                EpiRes E{p.in[I_CTX], X1C, nullptr, nullptr, mod + 2 * DM, 0.5f, 8};
                GEMM_RUN(4, g, S, E);
            } else { phase_norm(p, p.out, X1C, 0, ML, p.in[I_NMIX], 3, bid - 64, G - 64); prep_tiles(p, shm, 19200, 22016, bid - 64, G - 64); }
        }
        PHASE_BEGIN(6) {
            if (split_ctx) { phase_norm(p, p.out, X1C, ML, MT, p.in[I_NMIX], 3, bid, G); grid.sync(); }
            pg8::Gemm g{ABUF, (const bf16_t*)(p.ws + WS_WIN), ML, INC, DM};
            pg8::StaticOrder S; S.init(g.M, g.N, G, bid, 96);
            EpiBf16 E{CB, INC, (bf16_t*)(p.ws + WS_PXC), 3072};
            GEMM_RUN(6, g, S, E);
            if (split_ctx && G == 256 && bid >= 96) prep_tiles(p, shm, 12544, 13568, bid - 96, G - 96);
            else if (split_ctx && G != 256) prep_tiles(p, shm, 12544, 13568, bid, G);
        } PHASE_BEGIN(7) {
#if HG_MFMA
            if (G >= 256) { if (bid < 128) hgrn_mfma_item(p, bid, shm); else { phase_shortconv(p, shm, bid - 128, G - 128); if (split_ctx) prep_tiles(p, shm, 13568, 19200, bid - 128, G - 128); } }
            else if (split_ctx) {   phase_shortconv(p, shm, bid, G); prep_tiles(p, shm, 13568, 19200, bid, G); for (int it = bid; it < 128; it += G) hgrn_mfma_item(p, it, shm); }
            else { phase_shortconv(p, shm, bid, G); for (int it = bid; it < 128; it += G) hgrn_mfma_item(p, it, shm); }
#else
            phase_shortconv(p, shm, bid, G);
            for (int it = bid; it < 256; it += G) hgrn_item(p, it, shm);
#endif
        } PHASE_BEGIN(8) {
            for (int c = bid; c < 1024; c += G) hyena_item(p, c, shm);
            phase_readout(p);
        } PHASE_BEGIN(9) phase_ytrans(p, shm);
        PHASE_BEGIN(10) {
            pg8::Gemm g{ABUF, (const bf16_t*)(p.ws + WS_WOUT), ML, DM, DM};
            pg8::StaticOrder S; S.init(g.M, g.N, G, bid, 0);
            EpiRes E{p.out, p.out, nullptr, nullptr, mod + 5 * DM, 1.0f};
            GEMM_RUN(10, g, S, E);
        } PHASE_BEGIN(11) phase_norm(p, p.out, nullptr, 0, ML, p.in[I_NFFN2], 6, bid, G);
        PHASE_BEGIN(12) {
            pg8::Gemm g{ABUF, (const bf16_t*)(p.ws + WS_W13B), ML, 2 * DFF, DM};
            pg8::StaticOrder S; S.init(g.M, g.N, G, bid, 0);
            EpiSwiGLU E{CB};
            GEMM_RUN(12, g, S, E);
        } PHASE_BEGIN(13) {
            pg8::Gemm g{CB, (const bf16_t*)(p.ws + WS_W2B), ML, DM, DFF};
            pg8::StaticOrder S; S.init(g.M, g.N, G, bid, 0);
            EpiRes E{p.out, p.out, nullptr, nullptr, mod + 8 * DM, 0.5f};
            GEMM_RUN(13, g, S, E);
        } PHASE_BEGIN(14) phase_final_norm(p);
    if (TSEL) { const unsigned long long now_ = wall_clock64(); if (TSEL & (1 << 14)) tacc += now_ - tprev; if (blockIdx.x == 0 && threadIdx.x == 0) p.out[4096 * 2048 + 5] += (float)tacc * 0.0001f; }
}

extern "C" void kernel_launch(void* const* d_in, const int* in_sizes, int n_in, void* d_out, int out_size, void* d_ws, size_t ws_size, hipStream_t stream) {
    static int grid_blocks = 0;
    if (grid_blocks == 0) {
        if (n_in != 31 || out_size != ML * DM || ws_size < WS_END + 64) { fprintf(stderr, "kernel_launch: unexpected shapes (n_in %d out %d ws %zu need %zu)\n", n_in, out_size, ws_size, (size_t)WS_END); grid_blocks = -1; return; }
        int dev = 0, cus = 0, per_cu = 0;
        hipGetDevice(&dev);
        hipDeviceGetAttribute(&cus, hipDeviceAttributeMultiprocessorCount, dev);
        if (hipFuncSetAttribute((const void*)mega, hipFuncAttributeMaxDynamicSharedMemorySize, LDS_BYTES) != hipSuccess) { fprintf(stderr, "kernel_launch: hipFuncSetAttribute failed\n"); grid_blocks = -1; return; }
        if (hipOccupancyMaxActiveBlocksPerMultiprocessor(&per_cu, (const void*)mega, 512, LDS_BYTES) != hipSuccess || per_cu < 1) { fprintf(stderr, "kernel_launch: occupancy query failed (%d)\n", per_cu); per_cu = 1; (void)hipGetLastError(); }
        grid_blocks = cus * per_cu;
    }
    if (grid_blocks < 0) return;
    Params p;
    memset(&p, 0, sizeof(p));
    for (int i = 0; i < 31; ++i) p.in[i] = (const float*)d_in[i];
    p.out = (float*)d_out; p.ws = (unsigned char*)d_ws;
#if MULTI_LAUNCH
    for (int ph = 0; ph < NPH; ++ph) {
        p.ph_lo = ph; p.ph_hi = ph + 1;
        hipLaunchKernelGGL(mega, dim3(grid_blocks), dim3(512), LDS_BYTES, stream, p);
#if ROWCHK
        { const int w = (ph == 4) ? 0 : (ph == 6) ? 1 : (ph == 7) ? 8 : (ph == 8) ? 9 : (ph == 9) ? 2 : (ph == 10) ? 3 : (ph == 13) ? 4 : (ph == 14) ? 5 : -1;
          if (w >= 0) { p.ph_lo = 300 + w; p.ph_hi = 301 + w; hipLaunchKernelGGL(mega, dim3(256), dim3(512), LDS_BYTES, stream, p); }
          if (ph == 7) { p.ph_lo = 310; p.ph_hi = 311; hipLaunchKernelGGL(mega, dim3(256), dim3(512), LDS_BYTES, stream, p); }
          if (ph == 14) { p.ph_lo = 306; p.ph_hi = 307; hipLaunchKernelGGL(mega, dim3(256), dim3(512), LDS_BYTES, stream, p); } }
#endif
#if DEBUG_CHECK
        if (DBG_MASK & (1 << ph)) { p.ph_lo = 100 + ph; p.ph_hi = 101 + ph; hipLaunchKernelGGL(mega, dim3(grid_blocks), dim3(512), LDS_BYTES, stream, p); }
        if (ph == NPH - 1) { p.ph_lo = 200; p.ph_hi = 201 + DBG_SLOT; hipLaunchKernelGGL(mega, dim3(grid_blocks), dim3(512), LDS_BYTES, stream, p); }
#endif
    }
#else
    p.ph_lo = 0; p.ph_hi = NPH;
    void* args[] = {&p};
    hipError_t e = hipLaunchCooperativeKernel((const void*)mega, dim3(grid_blocks), dim3(512), args, LDS_BYTES, stream);
    if (e != hipSuccess) fprintf(stderr, "cooperative launch failed: %s (grid %d)\n", hipGetErrorString(e), grid_blocks);
#endif
}
```

```cpp
#include <hip/hip_runtime.h>
#include <hip/hip_cooperative_groups.h>
#include <cstdio>
#include <cstring>
namespace cg = cooperative_groups;

#ifndef ONLY_PH
#define ONLY_PH -1
#endif
#define PH(n) (p.ph_lo <= (n) && (n) < p.ph_hi && (ONLY_PH < 0 || ONLY_PH == (n)))
#define PHASE_BEGIN(n) if (p.ph_lo < (n) && (n) < p.ph_hi) { grid.sync(); if (TSEL) { const unsigned long long now_ = wall_clock64(); if (TSEL & (1 << ((n) - 1))) tacc += now_ - tprev; tprev = now_; } } if (PH(n))
#ifndef HY_SCALE
#define HY_SCALE 1.0f
#endif
#ifndef HG_SCALE
#define HG_SCALE 1.0f
#endif
#ifndef SKIP_CTX
#define SKIP_CTX 0
#endif
#ifndef DEBUG_CHECK
#define DEBUG_CHECK 0
#endif
#ifndef DBG_SLOT
#define DBG_SLOT 0
#endif
#ifndef DBG_MASK
#define DBG_MASK 0x0
#endif
#ifndef SIMPLE_GEMM
#define SIMPLE_GEMM 0x0
#endif
#ifndef FN_NOGAIN
#define FN_NOGAIN 0
#endif
#ifndef ROWCHK
#define ROWCHK 0
#endif
#ifndef ROWCHK_TOL
#define ROWCHK_TOL 1e-5f
#endif
#ifndef HGCHK_TOL
#define HGCHK_TOL 1e-4f
#endif
#ifndef TSEL
#define TSEL 0
#endif
#ifndef HG_MFMA
#define HG_MFMA 1
#endif
#ifndef MULTI_LAUNCH
#define MULTI_LAUNCH 0
#endif

#define LAS __attribute__((address_space(3)))
typedef unsigned short bf16_t;
typedef short bf16x8 __attribute__((ext_vector_type(8)));
typedef float f32x4 __attribute__((ext_vector_type(4)));
typedef unsigned u32x4 __attribute__((ext_vector_type(4)));
typedef unsigned u32x2 __attribute__((ext_vector_type(2)));

constexpr int DM = 2048, NB = 8, SEQ = 4096, CTXL = 256, DFF = 5632, MODC = 18432, HGW = 1024, INC = 8192;
constexpr int ML = NB * SEQ, MC = NB * CTXL, MT = ML + MC;
constexpr int NPH = 15;
constexpr int LDS_BYTES = 131072;

constexpr size_t WS_WIN = 0;
constexpr size_t WS_WOUT = WS_WIN + (size_t)INC * DM * 2;
constexpr size_t WS_W13B = WS_WOUT + (size_t)DM * DM * 2;
constexpr size_t WS_W2B = WS_W13B + (size_t)2 * DFF * DM * 2;
constexpr size_t WS_MODP = WS_W2B + (size_t)DM * DFF * 2;
constexpr size_t WS_MOD = WS_MODP + (size_t)8 * 9 * MODC * 4;
constexpr size_t WS_HID3 = WS_MOD + (size_t)9 * MODC * 4;
constexpr size_t WS_X1C = WS_HID3 + (size_t)64 * 4096 * 4;
constexpr size_t WS_PXC = WS_X1C + (size_t)MC * DM * 4;
constexpr size_t WS_ABUF = WS_PXC + (size_t)MC * 3072 * 2;
constexpr size_t WS_C = WS_ABUF + (size_t)MT * DM * 2;
constexpr size_t WS_F = WS_C + (size_t)ML * INC * 2;
constexpr size_t WS_W13A = WS_F;
constexpr size_t WS_W2A = WS_W13A + (size_t)2 * DFF * DM * 2;
constexpr size_t WS_END = WS_F + (size_t)NB * 3072 * SEQ * 2;
static_assert((size_t)MT * DFF * 2 <= (size_t)ML * INC * 2, "H fits in region C");

struct Params {
    const float* in[31];
    float* out;
    unsigned char* ws;
    int ph_lo, ph_hi;
};
enum { I_X = 0, I_C, I_CTX, I_CCTX, I_ADAW, I_ADAB, I_NFFN1, I_F1W1, I_F1W3, I_F1W2, I_NMIX, I_WIN, I_LB, I_HGN, I_HCW, I_HCB, I_FW1, I_FB1, I_FW2, I_FB2, I_FW3, I_FB3, I_FFREQ, I_FWO, I_HYD, I_WOUT, I_NFFN2, I_F2W1, I_F2W3, I_F2W2, I_FNORM };

__device__ __forceinline__ unsigned cvt_pk_bf16(float lo, float hi) { unsigned r; asm volatile("v_cvt_pk_bf16_f32 %0, %1, %2" : "=v"(r) : "v"(lo), "v"(hi)); return r; }
typedef __bf16 bf16v2_t __attribute__((ext_vector_type(2)));
typedef float f32x2_t __attribute__((ext_vector_type(2)));
__device__ __forceinline__ unsigned cvt_pk_safe(float lo, float hi) { const f32x2_t v = {lo, hi}; const bf16v2_t b = __builtin_convertvector(v, bf16v2_t); return __builtin_bit_cast(unsigned, b); }
__device__ __forceinline__ float bf_lo(unsigned w) { return __uint_as_float(w << 16); }
__device__ __forceinline__ float bf_hi(unsigned w) { return __uint_as_float(w & 0xffff0000u); }
__device__ __forceinline__ float bf2f(bf16_t h) { return __uint_as_float(((unsigned)h) << 16); }
__device__ __forceinline__ bf16_t f2bf(float f) { return (bf16_t)(cvt_pk_bf16(f, 0.f) & 0xffffu); }
__device__ __forceinline__ float sigmoidf_(float x) { return __builtin_amdgcn_rcpf(1.0f + __expf(-x)); }
__device__ __forceinline__ float siluf_(float x) { return x * sigmoidf_(x); }
__device__ __forceinline__ int tid_opaque() { int t = threadIdx.x; asm volatile("" : "+v"(t)); return t; }
#define HW_COS(r) __builtin_amdgcn_cosf(r)
#define HW_SIN(r) __builtin_amdgcn_sinf(r)
#define SYNC() __syncthreads()
__device__ __forceinline__ float sin_rad(float a) { float r = a * 0.15915494309189535f; r -= rintf(r); return HW_SIN(r); }
__device__ __forceinline__ float cos_rad(float a) { float r = a * 0.15915494309189535f; r -= rintf(r); return HW_COS(r); }
__device__ __forceinline__ float wave_sum(float v) {
#pragma unroll
    for (int o = 32; o > 0; o >>= 1) v += __shfl_xor(v, o);
    return v;
}

#define FPAD(i) ((i) + (((i) >> 5) << 1))
#define FFT_LDS_ELEMS 8704
__device__ __forceinline__ float2 cadd(float2 a, float2 b) { return make_float2(a.x + b.x, a.y + b.y); }
__device__ __forceinline__ float2 csub(float2 a, float2 b) { return make_float2(a.x - b.x, a.y - b.y); }
__device__ __forceinline__ float2 cmul(float2 a, float2 b) { return make_float2(a.x * b.x - a.y * b.y, a.x * b.y + a.y * b.x); }
__device__ __forceinline__ float2 cmulc(float2 a, float2 b) { return make_float2(a.x * b.x + a.y * b.y, a.y * b.x - a.x * b.y); }
__device__ __forceinline__ float2 twid(float rev) { return make_float2(HW_COS(rev), -HW_SIN(rev)); }

template <int K> struct W16 {
    static constexpr float X = (K == 0) ? 1.f : (K == 1) ? 0.92387953251f : (K == 2) ? 0.70710678119f : (K == 3) ? 0.38268343237f : (K == 4) ? 0.f : (K == 5) ? -0.38268343237f : (K == 6) ? -0.70710678119f : -0.92387953251f;
    static constexpr float Y = (K == 0) ? 0.f : (K == 1) ? -0.38268343237f : (K == 2) ? -0.70710678119f : (K == 3) ? -0.92387953251f : (K == 4) ? -1.f : (K == 5) ? -0.92387953251f : (K == 6) ? -0.70710678119f : -0.38268343237f;
};

template <int U, int ML_, bool INV> __device__ __forceinline__ void fft_bfly_group(float2 (&v)[16], float2 Tu) {
    constexpr int half = 8 >> U;
    const float2 tw = (ML_ == 0) ? Tu : cmul(Tu, make_float2(W16<(ML_ << U)>::X, W16<(ML_ << U)>::Y));
#pragma unroll
    for (int bs = 0; bs < 16; bs += 2 * half) {
        const int m = bs + ML_;
        if (!INV) { const float2 a = v[m], b = v[m + half]; v[m] = cadd(a, b); v[m + half] = cmul(csub(a, b), tw); }
        else { const float2 a = v[m], b = cmulc(v[m + half], tw); v[m] = cadd(a, b); v[m + half] = csub(a, b); }
    }
}
template <int U, bool INV> __device__ __forceinline__ void fft_stage(float2 (&v)[16], float2 Tu) {
    constexpr int half = 8 >> U;
    fft_bfly_group<U, 0, INV>(v, Tu);
    if constexpr (half > 1) fft_bfly_group<U, 1, INV>(v, Tu);
    if constexpr (half > 2) { fft_bfly_group<U, 2, INV>(v, Tu); fft_bfly_group<U, 3, INV>(v, Tu); }
    if constexpr (half > 4) { fft_bfly_group<U, 4, INV>(v, Tu); fft_bfly_group<U, 5, INV>(v, Tu); fft_bfly_group<U, 6, INV>(v, Tu); fft_bfly_group<U, 7, INV>(v, Tu); }
}
template <int P, bool INV> __device__ __forceinline__ void fft16(float2 (&v)[16], int L) {
    const float sc = 1.0f / (float)(1 << (P + 4));
    const float2 T0 = twid((float)L * sc), T1 = twid((float)(L << 1) * sc), T2 = twid((float)(L << 2) * sc), T3 = twid((float)(L << 3) * sc);
    if (!INV) { fft_stage<0, false>(v, T0); fft_stage<1, false>(v, T1); fft_stage<2, false>(v, T2); fft_stage<3, false>(v, T3); }
    else { fft_stage<3, true>(v, T3); fft_stage<2, true>(v, T2); fft_stage<1, true>(v, T1); fft_stage<0, true>(v, T0); }
}
__device__ __forceinline__ int fidxA(int tid, int m) { return tid + 512 * m; }
__device__ __forceinline__ int fidxB(int tid, int m) { return ((tid >> 5) << 9) + (m << 5) + (tid & 31); }
__device__ __forceinline__ int fidxC(int tid, int m) { return ((tid >> 1) << 5) + (m << 1) + (tid & 1); }

#define FFT_FWD_TO_PAIRS(v, buf, tid_) do { int ftid = (tid_); asm volatile("" : "+v"(ftid)); \
    fft16<9, false>(v, ftid); \
    _Pragma("unroll") for (int m = 0; m < 16; ++m) buf[FPAD(fidxA(ftid, m))] = v[m]; \
    SYNC(); \
    _Pragma("unroll") for (int m = 0; m < 16; ++m) v[m] = buf[FPAD(fidxB(ftid, m))]; \
    fft16<5, false>(v, ftid & 31); \
    _Pragma("unroll") for (int m = 0; m < 16; ++m) buf[FPAD(fidxB(ftid, m))] = v[m]; \
    SYNC(); \
    _Pragma("unroll") for (int m = 0; m < 16; ++m) v[m] = buf[FPAD(fidxC(ftid, m))]; \
    fft16<1, false>(v, ftid & 1); \
    _Pragma("unroll") for (int m = 0; m < 16; ++m) buf[FPAD(fidxC(ftid, m))] = v[m]; \
    SYNC(); \
    _Pragma("unroll") for (int q = 0; q < 8; ++q) { const int j2 = 2 * (ftid + 512 * q); const float4 pr = *(const float4*)&buf[FPAD(j2)]; \
        v[2 * q] = make_float2(pr.x + pr.z, pr.y + pr.w); v[2 * q + 1] = make_float2(pr.x - pr.z, pr.y - pr.w); } \
} while (0)

#define FFT_INV_FROM_PAIRS(v, buf, tid_) do { int ftid = (tid_); asm volatile("" : "+v"(ftid)); \
    _Pragma("unroll") for (int q = 0; q < 8; ++q) { const int j2 = 2 * (ftid + 512 * q); const float2 a = v[2 * q], b = v[2 * q + 1]; \
        *(float4*)&buf[FPAD(j2)] = make_float4(a.x + b.x, a.y + b.y, a.x - b.x, a.y - b.y); } \
    SYNC(); \
    _Pragma("unroll") for (int m = 0; m < 16; ++m) v[m] = buf[FPAD(fidxC(ftid, m))]; \
    fft16<1, true>(v, ftid & 1); \
    _Pragma("unroll") for (int m = 0; m < 16; ++m) buf[FPAD(fidxC(ftid, m))] = v[m]; \
    SYNC(); \
    _Pragma("unroll") for (int m = 0; m < 16; ++m) v[m] = buf[FPAD(fidxB(ftid, m))]; \
    fft16<5, true>(v, ftid & 31); \
    _Pragma("unroll") for (int m = 0; m < 16; ++m) buf[FPAD(fidxB(ftid, m))] = v[m]; \
    SYNC(); \
    _Pragma("unroll") for (int m = 0; m < 16; ++m) v[m] = buf[FPAD(fidxA(ftid, m))]; \
    fft16<9, true>(v, ftid); \
} while (0)

namespace pg8 {
constexpr int BM = 256, BK = 64, HALF = 128, HTB = HALF * BK * 2, STAGE_BYTES = 8 * HTB, NXCD = 8, WGM = 8;
__device__ __forceinline__ int lds_byte(int r, int c) { const int st = (r >> 4) * 2 + (c >> 5), rr = r & 15, cc = c & 31, ob = rr * 64 + cc * 2; return st * 1024 + (ob ^ (((ob >> 9) & 1) << 5)); }
__device__ __forceinline__ void stage_rc(int b, int& R, int& C) { const int st = b / 1024, sb = b % 1024, swz = sb ^ (((sb >> 9) & 1) << 5); R = (st >> 1) * 16 + swz / 64; C = (st & 1) * 32 + (swz % 64) / 2; }
__device__ __forceinline__ int perm32(int rho) { const int n = rho >> 4, i = rho & 15; return 8 * (i >> 2) + 4 * n + (i & 3); }
struct Unit { int pm, pn; };
struct Gemm { const bf16_t* A; const bf16_t* Bt; int M, N, K; };
struct StaticOrder {
    int nM, nN, nwg, G, c, extra;
    __device__ void init(int M, int N, int G_, int c_, int extra_) { nM = M / BM; nN = N / BM; nwg = nM * nN; G = G_; c = c_; extra = extra_; }
    __device__ bool next(int i, Unit& u) const {
        const long L = (long)i * G + c;
        if (L >= nwg) { const int e = (int)(L - nwg); if (e >= extra) return false; u.pm = 128 + (e & 7); u.pn = e >> 3; return true; }
        int wgid = (int)L; { const int q = nwg / NXCD, r = nwg % NXCD, xcd = wgid % NXCD, off = wgid / NXCD; wgid = (xcd < r ? xcd * (q + 1) : r * (q + 1) + (xcd - r) * q) + off; }
        const int nig = WGM * nN, gid = wgid / nig, fm = gid * WGM, gsz = (nM - fm) < WGM ? (nM - fm) : WGM;
        u.pm = fm + ((wgid % nig) % gsz); u.pn = (wgid % nig) / gsz; return true;
    }
    __device__ __forceinline__ void a_ready(const Unit&) const {}
    __device__ __forceinline__ void done(const Unit&) const {}
};

template <class Epi, class Sched>
__device__ __forceinline__ void gemm_phase(LAS unsigned char* lds, const Gemm g, const Sched& S, const Epi& E) {
    const int tid = tid_opaque(), wid = __builtin_amdgcn_readfirstlane(tid >> 6), lane = tid & 63, wr = wid >> 2, wc = wid & 3, fr = lane & 15, fq = lane >> 4;
    const int K = g.K, nt = K / BK;
    unsigned voffA[2], voffB[2];
#pragma unroll
    for (int i = 0; i < 2; ++i) { int R, C; stage_rc(tid * 16 + i * 8192, R, C); const int Rb = Epi::PERM ? ((R & ~31) + perm32(R & 31)) : R;
        voffA[i] = (unsigned)(R * K + C) * 2u; voffB[i] = (unsigned)(Rb * K + C) * 2u; }
    const size_t kstep = (size_t)(BK * 2);
    const size_t hstep = (size_t)HALF * K * 2;
    const size_t tstep = 2 * hstep;
    const unsigned ldsw = (unsigned)wid * 1024u;
    const int aoff = lds_byte(wr * 64 + fr, fq * 8), boff = lds_byte(wc * 32 + fr, fq * 8);
#define PG8_SA(b, h) (((b) * 2 + (h)) * HTB)
#define PG8_SB(b, h) ((4 + (b) * 2 + (h)) * HTB)
#define PG8_STAGE(bufoff, gbase, voff) do { _Pragma("unroll") for (int _i = 0; _i < 2; ++_i) \
        __builtin_amdgcn_global_load_lds((const unsigned*)((const char*)(gbase) + (voff)[_i]), (LAS unsigned*)(lds + (bufoff) + ldsw + _i * 8192), 16, 0, 0); } while (0)
#define PG8_LDA(dst, b, h) do { _Pragma("unroll") for (int m = 0; m < 4; ++m) _Pragma("unroll") for (int k = 0; k < 2; ++k) dst[m][k] = *(const LAS bf16x8*)(lds + PG8_SA(b, h) + aoff + m * 2048 + k * 1024); } while (0)
#define PG8_LDB(dst, b, h) do { _Pragma("unroll") for (int n = 0; n < 2; ++n) _Pragma("unroll") for (int k = 0; k < 2; ++k) dst[n][k] = *(const LAS bf16x8*)(lds + PG8_SB(b, h) + boff + n * 2048 + k * 1024); } while (0)
#define PG8_MMA(ai, bj, At, Bt) do { __builtin_amdgcn_s_setprio(1); _Pragma("unroll") for (int m = 0; m < 4; ++m) _Pragma("unroll") for (int n = 0; n < 2; ++n) _Pragma("unroll") for (int k = 0; k < 2; ++k) \
        acc[ai][bj][m][n] = __builtin_amdgcn_mfma_f32_16x16x32_bf16(Bt[n][k], At[m][k], acc[ai][bj][m][n], 0, 0, 0); __builtin_amdgcn_s_setprio(0); } while (0)
#define PG8_WAIT_V(n) asm volatile("s_waitcnt vmcnt(" #n ")" ::: "memory")
#define PG8_WAIT_L(n) asm volatile("s_waitcnt lgkmcnt(" #n ")" ::: "memory")
#define PG8_BAR __builtin_amdgcn_s_barrier()
#define PG8_SCHED __builtin_amdgcn_sched_barrier(0)
    Unit cur, nxt; int ui = 0;
    if (!S.next(0, cur)) return;
    f32x4 acc[2][2][4][2];
#pragma unroll
    for (int a = 0; a < 2; ++a)
#pragma unroll
        for (int b = 0; b < 2; ++b)
#pragma unroll
            for (int m = 0; m < 4; ++m)
#pragma unroll
                for (int n = 0; n < 2; ++n) acc[a][b][m][n] = (f32x4){0.f, 0.f, 0.f, 0.f};
    bf16x8 At[4][2], B0[2][2], B1[2][2];
    const char* cA = (const char*)g.A + (size_t)cur.pm * tstep; const char* cB = (const char*)g.Bt + (size_t)cur.pn * tstep;
    S.a_ready(cur);
    PG8_STAGE(PG8_SB(0, 0), cB, voffB); PG8_STAGE(PG8_SA(0, 0), cA, voffA); PG8_STAGE(PG8_SB(0, 1), cB + hstep, voffB); PG8_STAGE(PG8_SA(0, 1), cA + hstep, voffA);
    if (wr == 1) PG8_BAR;
    PG8_WAIT_V(4); PG8_BAR;
    PG8_STAGE(PG8_SB(1, 0), cB + kstep, voffB); PG8_STAGE(PG8_SA(1, 0), cA + kstep, voffA); PG8_STAGE(PG8_SB(1, 1), cB + hstep + kstep, voffB);
    PG8_WAIT_V(6); PG8_BAR;
    for (;;) {
        const bool has_next = S.next(ui + 1, nxt);
        const char* nA = has_next ? (const char*)g.A + (size_t)nxt.pm * tstep : cA; const char* nB = has_next ? (const char*)g.Bt + (size_t)nxt.pn * tstep : cB;
        for (int t = 0; t < nt; t += 2) {
            const bool last = (t == nt - 2);
            const char* a1 = cA + (size_t)(t + 1) * kstep;
            const char* a2 = last ? nA : cA + (size_t)(t + 2) * kstep; const char* b2 = last ? nB : cB + (size_t)(t + 2) * kstep;
            const char* a3 = a2 + kstep; const char* b3 = b2 + kstep;
            if (last && has_next) S.a_ready(nxt);
            PG8_LDB(B0, 0, 0); PG8_SCHED; PG8_LDA(At, 0, 0); PG8_STAGE(PG8_SA(1, 1), a1 + hstep, voffA);
            PG8_WAIT_L(8); PG8_BAR; PG8_WAIT_L(0); PG8_MMA(0, 0, At, B0); PG8_BAR; PG8_SCHED;
            PG8_LDB(B1, 0, 1); PG8_STAGE(PG8_SB(0, 0), b2, voffB);
            PG8_BAR; PG8_WAIT_L(0); PG8_MMA(0, 1, At, B1); PG8_BAR;
            PG8_LDA(At, 0, 1); PG8_STAGE(PG8_SA(0, 0), a2, voffA);
            PG8_BAR; PG8_WAIT_L(0); PG8_MMA(1, 0, At, B0); PG8_BAR; PG8_SCHED;
            PG8_STAGE(PG8_SB(0, 1), b2 + hstep, voffB);
            PG8_WAIT_V(6); PG8_BAR; PG8_MMA(1, 1, At, B1); PG8_BAR;
            PG8_LDB(B0, 1, 0); PG8_SCHED; PG8_LDA(At, 1, 0); PG8_STAGE(PG8_SA(0, 1), a2 + hstep, voffA);
            PG8_WAIT_L(8); PG8_BAR; PG8_WAIT_L(0); PG8_MMA(0, 0, At, B0); PG8_BAR; PG8_SCHED;
            PG8_LDB(B1, 1, 1); PG8_STAGE(PG8_SB(1, 0), b3, voffB);
            PG8_BAR; PG8_WAIT_L(0); PG8_MMA(0, 1, At, B1); PG8_BAR;
            PG8_LDA(At, 1, 1); PG8_STAGE(PG8_SA(1, 0), a3, voffA);
            PG8_BAR; PG8_WAIT_L(0); PG8_MMA(1, 0, At, B0); PG8_BAR; PG8_SCHED;
            PG8_STAGE(PG8_SB(1, 1), b3 + hstep, voffB);
            PG8_WAIT_V(6); PG8_BAR; PG8_MMA(1, 1, At, B1); PG8_BAR;
        }
        E(acc, cur, wr, wc, fr, fq); S.done(cur);
        if (!has_next) break;
#pragma unroll
        for (int a = 0; a < 2; ++a)
#pragma unroll
            for (int b = 0; b < 2; ++b)
#pragma unroll
                for (int m = 0; m < 4; ++m)
#pragma unroll
                    for (int n = 0; n < 2; ++n) acc[a][b][m][n] = (f32x4){0.f, 0.f, 0.f, 0.f};
        cur = nxt; cA = nA; cB = nB; ++ui;
    }
    PG8_WAIT_V(0);
    if (wr == 0) PG8_BAR;
    PG8_BAR;
#undef PG8_SA
#undef PG8_SB
#undef PG8_STAGE
#undef PG8_LDA
#undef PG8_LDB
#undef PG8_MMA
#undef PG8_WAIT_V
#undef PG8_WAIT_L
#undef PG8_BAR
#undef PG8_SCHED
}
}

struct EpiSwiGLU {
    static constexpr bool PERM = true;
    bf16_t* H;
    __device__ __forceinline__ void operator()(const f32x4 (&acc)[2][2][4][2], const pg8::Unit& u, int wr, int wc, int fr, int fq) const {
        const int row0 = u.pm * 256 + wr * 64 + fr, col0 = u.pn * 128 + wc * 32 + 8 * fq;
#pragma unroll
        for (int ai = 0; ai < 2; ++ai)
#pragma unroll
            for (int m = 0; m < 4; ++m) {
                bf16_t* rowp = H + (size_t)(row0 + ai * 128 + m * 16) * DFF + col0;
                float h[8];
#pragma unroll
                for (int n = 0; n < 2; ++n)
#pragma unroll
                    for (int j = 0; j < 4; ++j) { const float gt = acc[ai][0][m][n][j], up = acc[ai][1][m][n][j]; h[n * 4 + j] = siluf_(gt) * up; }
                u32x4 w; w.x = cvt_pk_bf16(h[0], h[1]); w.y = cvt_pk_bf16(h[2], h[3]); w.z = cvt_pk_bf16(h[4], h[5]); w.w = cvt_pk_bf16(h[6], h[7]);
                *(u32x4*)rowp = w;
            }
    }
};
struct EpiBf16 {
    static constexpr bool PERM = true;
    bf16_t* O; int ldl; bf16_t* OC; int ldc;
    __device__ __forceinline__ void operator()(const f32x4 (&acc)[2][2][4][2], const pg8::Unit& u, int wr, int wc, int fr, int fq) const {
        const bool isc = u.pm >= 128;
        bf16_t* base = isc ? OC : O; const int ld = isc ? ldc : ldl;
        const int row0 = (isc ? (u.pm - 128) : u.pm) * 256 + wr * 64 + fr, col0 = u.pn * 256 + wc * 32 + 8 * fq;
#pragma unroll
        for (int ai = 0; ai < 2; ++ai)
#pragma unroll
            for (int m = 0; m < 4; ++m) {
                bf16_t* rowp = base + (size_t)(row0 + ai * 128 + m * 16) * ld + col0;
#pragma unroll
                for (int bj = 0; bj < 2; ++bj) {
                    const f32x4 v0 = acc[ai][bj][m][0], v1 = acc[ai][bj][m][1];
                    u32x4 w; w.x = cvt_pk_bf16(v0[0], v0[1]); w.y = cvt_pk_bf16(v0[2], v0[3]); w.z = cvt_pk_bf16(v1[0], v1[1]); w.w = cvt_pk_bf16(v1[2], v1[3]);
                    *(u32x4*)(rowp + bj * 128) = w;
                }
            }
    }
};
struct EpiRes {
    static constexpr bool PERM = false;
    const float* srcL; float* dstL; const float* srcC; float* dstC; const float* gate; float coef; int frow = -1;
    __device__ __forceinline__ void operator()(const f32x4 (&acc)[2][2][4][2], const pg8::Unit& u, int wr, int wc, int fr, int fq) const {
        const bool isc = u.pm >= 128;
        const float* src = isc ? srcC : srcL; float* dst = isc ? dstC : dstL;
        const int modrow = (frow >= 0) ? frow : (isc ? 8 : (u.pm >> 4));
        const int row0 = (isc ? (u.pm - 128) : u.pm) * 256 + wr * 64 + fr, col0 = u.pn * 256 + wc * 32 + 4 * fq;
        const float* gp = gate + (size_t)modrow * MODC + col0;
        f32x4 gv[2][2];
#pragma unroll
        for (int bj = 0; bj < 2; ++bj)
#pragma unroll
            for (int n = 0; n < 2; ++n) gv[bj][n] = *(const f32x4*)(gp + bj * 128 + n * 16) * coef;
#pragma unroll
        for (int ai = 0; ai < 2; ++ai) {
            f32x4 sv[4][2][2];
#pragma unroll
            for (int m = 0; m < 4; ++m) {
                const size_t ro = (size_t)(row0 + ai * 128 + m * 16) * DM + col0;
#pragma unroll
                for (int bj = 0; bj < 2; ++bj)
#pragma unroll
                    for (int n = 0; n < 2; ++n) sv[m][bj][n] = *(const f32x4*)(src + ro + bj * 128 + n * 16);
            }
            asm volatile("" ::: "memory");
#pragma unroll
            for (int m = 0; m < 4; ++m) {
                const size_t ro = (size_t)(row0 + ai * 128 + m * 16) * DM + col0;
#pragma unroll
                for (int bj = 0; bj < 2; ++bj)
#pragma unroll
                    for (int n = 0; n < 2; ++n) *(f32x4*)(dst + ro + bj * 128 + n * 16) = sv[m][bj][n] + gv[bj][n] * acc[ai][bj][m][n];
            }
            asm volatile("" ::: "memory");
        }
    }
};


template <class Epi, class Sched>
__device__ __forceinline__ void gemm_simple(const pg8::Gemm g, const Sched& S, const Epi& E) {
    const int tid = tid_opaque(), wid = tid >> 6, lane = tid & 63, wr = wid >> 2, wc = wid & 3, fr = lane & 15, fq = lane >> 4;
    const int K = g.K;
    pg8::Unit u;
    for (int i = 0; S.next(i, u); ++i) {
        f32x4 acc[2][2][4][2];
#pragma unroll
        for (int a = 0; a < 2; ++a)
#pragma unroll
            for (int b = 0; b < 2; ++b)
#pragma unroll
                for (int m = 0; m < 4; ++m)
#pragma unroll
                    for (int n = 0; n < 2; ++n) acc[a][b][m][n] = (f32x4){0.f, 0.f, 0.f, 0.f};
        const bf16_t* Ab = g.A + (size_t)(u.pm * 256 + wr * 64 + fr) * K + fq * 8;
        const bf16_t* Bb0 = g.Bt + (size_t)(u.pn * 256 + wc * 32 + (Epi::PERM ? pg8::perm32(fr) : fr)) * K + fq * 8;
        const bf16_t* Bb1 = g.Bt + (size_t)(u.pn * 256 + wc * 32 + (Epi::PERM ? pg8::perm32(16 + fr) : 16 + fr)) * K + fq * 8;
#pragma unroll 1
        for (int k0 = 0; k0 < K; k0 += 32) {
            bf16x8 a[2][4], b[2][2];
#pragma unroll
            for (int ai = 0; ai < 2; ++ai)
#pragma unroll
                for (int m = 0; m < 4; ++m) a[ai][m] = *(const bf16x8*)(Ab + (size_t)(ai * 128 + m * 16) * K + k0);
#pragma unroll
            for (int bj = 0; bj < 2; ++bj) { b[bj][0] = *(const bf16x8*)(Bb0 + (size_t)(bj * 128) * K + k0); b[bj][1] = *(const bf16x8*)(Bb1 + (size_t)(bj * 128) * K + k0); }
#pragma unroll
            for (int ai = 0; ai < 2; ++ai)
#pragma unroll
                for (int bj = 0; bj < 2; ++bj)
#pragma unroll
                    for (int m = 0; m < 4; ++m)
#pragma unroll
                        for (int n = 0; n < 2; ++n) acc[ai][bj][m][n] = __builtin_amdgcn_mfma_f32_16x16x32_bf16(b[bj][n], a[ai][m], acc[ai][bj][m][n], 0, 0, 0);
        }
        E(acc, u, wr, wc, fr, fq);
    }
}
#define GEMM_RUN(phn, g, S, E) do { if (SIMPLE_GEMM & (1 << (phn))) gemm_simple(g, S, E); else pg8::gemm_phase(lds, g, S, E); } while (0)

__device__ __forceinline__ void tr_tile(const float* __restrict__ src, int N, bf16_t* __restrict__ dst, int K, int k0, int n0, int rs, int off, float* tile) {
    const int tid = tid_opaque();
    const int c4 = (tid & 15) * 4;
#pragma unroll
    for (int pss = 0; pss < 2; ++pss) {
        const int r = (tid >> 4) + 32 * pss;
        const float4 x = *(const float4*)(src + (size_t)(k0 + r) * N + n0 + c4);
        float* t = tile + r * 65 + c4; t[0] = x.x; t[1] = x.y; t[2] = x.z; t[3] = x.w;
    }
    __syncthreads();
    const int n = tid >> 3, kq = tid & 7;
    float e[8];
#pragma unroll
    for (int j = 0; j < 8; ++j) e[j] = tile[(kq * 8 + j) * 65 + n];
    const int nn = n0 + n, row = (nn >> 7) * rs + off + (nn & 127);
    u32x4 w; w.x = cvt_pk_bf16(e[0], e[1]); w.y = cvt_pk_bf16(e[2], e[3]); w.z = cvt_pk_bf16(e[4], e[5]); w.w = cvt_pk_bf16(e[6], e[7]);
    *(u32x4*)(dst + (size_t)row * K + k0 + kq * 8) = w;
    __syncthreads();
}

__device__ __forceinline__ void prep_tiles(const Params& p, unsigned char* shm, int t_begin, int t_end, int start, int stride) {
    float* tile = (float*)shm;
    for (int t = t_begin + start; t < t_end; t += stride) {
        int job, lt = t;
        if (lt < 2816) job = 0; else if ((lt -= 2816) < 2816) job = 1; else if ((lt -= 2816) < 2816) job = 2; else if ((lt -= 2816) < 4096) job = 3;
        else if ((lt -= 4096) < 1024) job = 4; else if ((lt -= 1024) < 2816) job = 5; else if ((lt -= 2816) < 2816) job = 6; else { lt -= 2816; job = 7; }
        const float* src; bf16_t* dst; int K, N, rs = 128, off = 0;
        switch (job) {
            case 0: src = p.in[I_F1W1]; dst = (bf16_t*)(p.ws + WS_W13A); K = DM; N = DFF; rs = 256; break;
            case 1: src = p.in[I_F1W3]; dst = (bf16_t*)(p.ws + WS_W13A); K = DM; N = DFF; rs = 256; off = 128; break;
            case 2: src = p.in[I_F1W2]; dst = (bf16_t*)(p.ws + WS_W2A); K = DFF; N = DM; break;
            case 3: src = p.in[I_WIN]; dst = (bf16_t*)(p.ws + WS_WIN); K = DM; N = INC; break;
            case 4: src = p.in[I_WOUT]; dst = (bf16_t*)(p.ws + WS_WOUT); K = DM; N = DM; break;
            case 5: src = p.in[I_F2W1]; dst = (bf16_t*)(p.ws + WS_W13B); K = DM; N = DFF; rs = 256; break;
            case 6: src = p.in[I_F2W3]; dst = (bf16_t*)(p.ws + WS_W13B); K = DM; N = DFF; rs = 256; off = 128; break;
            default: src = p.in[I_F2W2]; dst = (bf16_t*)(p.ws + WS_W2B); K = DFF; N = DM; break;
        }
        const int nkt = K >> 6;
        const int kt = lt % nkt, ntl = lt / nkt;
        tr_tile(src, N, dst, K, kt * 64, ntl * 64, rs, off, tile);
    }
}

__device__ __forceinline__ void phase_prep(const Params& p, unsigned char* shm, bool defer_ffn2) {
    const int tid = tid_opaque(), G = gridDim.x, bid = blockIdx.x;
    if (defer_ffn2) { prep_tiles(p, shm, 0, 8448, bid, G); prep_tiles(p, shm, 10496, 12544, bid, G); }
    else prep_tiles(p, shm, 0, 22016, bid, G);
    {
        float* s = (float*)shm;
        float* modp = (float*)(p.ws + WS_MODP);
        for (int it = bid; it < 288; it += G) {
            const int cgp = it % 36, ks = it / 36;
            __syncthreads();
            if (tid < 256) {
#pragma unroll
                for (int j = 0; j < 9; ++j) { const float cv = (j < 8) ? p.in[I_C][j * DM + ks * 256 + tid] : p.in[I_CCTX][ks * 256 + tid]; s[j * 256 + tid] = siluf_(cv); }
            }
            __syncthreads();
            const int col = cgp * 512 + tid;
            const float* wp = p.in[I_ADAW] + (size_t)(ks * 256) * MODC + col;
            float acc[9];
#pragma unroll
            for (int j = 0; j < 9; ++j) acc[j] = 0.f;
#pragma unroll 2
            for (int k = 0; k < 256; k += 4) {
                const float w0 = wp[(size_t)(k + 0) * MODC], w1 = wp[(size_t)(k + 1) * MODC], w2 = wp[(size_t)(k + 2) * MODC], w3 = wp[(size_t)(k + 3) * MODC];
#pragma unroll
                for (int j = 0; j < 9; ++j) { const float4 sv = *(const float4*)&s[j * 256 + k]; acc[j] += sv.x * w0 + sv.y * w1 + sv.z * w2 + sv.w * w3; }
            }
#pragma unroll
            for (int j = 0; j < 9; ++j) modp[((size_t)ks * 9 + j) * MODC + col] = acc[j];
        }
        __syncthreads();
    }
    {
        float* z = (float*)shm;
        float* h1 = z + 8 * 36;
        float* h2 = h1 + 8 * 64;
        float* hid3T = (float*)(p.ws + WS_HID3);
        const int lg = tid >> 6, unit = tid & 63;
        const float fr = p.in[I_FFREQ][unit];
        for (int it = bid; it < 512; it += G) {
            const int lag = it * 8 + lg;
            __syncthreads();
            if (unit < 33) {
                float val;
                if (unit == 0) val = (float)lag / 4095.0f;
                else {
                    const int i = (unit - 1) & 15;
                    const float fb = 1e-4f + (float)i * ((15.0f - 1e-4f) / 15.0f);
                    const float ang = (0.0015339807878856412f * (float)lag) * fb;
                    val = (unit <= 16) ? cos_rad(ang) : -sin_rad(ang);
                }
                z[lg * 36 + unit] = val;
            }
            __syncthreads();
            float a = p.in[I_FB1][unit];
#pragma unroll 3
            for (int i = 0; i < 33; ++i) a += z[lg * 36 + i] * p.in[I_FW1][i * 64 + unit];
            h1[lg * 64 + unit] = sin_rad(fr * a);
            __syncthreads();
            a = p.in[I_FB2][unit];
#pragma unroll 8
            for (int i = 0; i < 64; ++i) a += h1[lg * 64 + i] * p.in[I_FW2][i * 64 + unit];
            h2[lg * 64 + unit] = sin_rad(fr * a);
            __syncthreads();
            a = p.in[I_FB3][unit];
#pragma unroll 8
            for (int i = 0; i < 64; ++i) a += h2[lg * 64 + i] * p.in[I_FW3][i * 64 + unit];
            hid3T[unit * 4096 + lag] = sin_rad(fr * a);
        }
        __syncthreads();
    }
}

__device__ __forceinline__ void phase_modreduce(const Params& p) {
    const float* modp = (const float*)(p.ws + WS_MODP);
    float* mod = (float*)(p.ws + WS_MOD);
    for (int i = blockIdx.x * 512 + tid_opaque(); i < 9 * MODC; i += gridDim.x * 512) {
        const int col = i % MODC;
        float a = p.in[I_ADAB][col];
#pragma unroll
        for (int ks = 0; ks < 8; ++ks) a += modp[(size_t)ks * 9 * MODC + i];
        mod[i] = a;
    }
}

__device__ __forceinline__ void phase_norm(const Params& p, const float* srcL, const float* srcC, int r_begin, int r_end, const float* gw, int sidx, int blk, int nblk) {
    const int tid = tid_opaque(); const int lane = tid & 63, gwv = blk * 8 + (tid >> 6), nw = nblk * 8; const int nrows = r_end - r_begin;
    const float* mod = (const float*)(p.ws + WS_MOD);
    bf16_t* A = (bf16_t*)(p.ws + WS_ABUF);
    const int per = (nrows + nw - 1) / nw, r_lo = r_begin + gwv * per, r_hi = (r_lo + per < r_end) ? (r_lo + per) : r_end;
    float4 g[8], s0[8], s1[8];
#pragma unroll
    for (int i = 0; i < 8; ++i) g[i] = *(const float4*)(gw + (i * 64 + lane) * 4);
    int cur = -1;
    for (int r = r_lo; r < r_hi; ++r) {
        const float* src = (r < ML) ? srcL + (size_t)r * DM : srcC + (size_t)(r - ML) * DM;
        const int mrow = (r < ML) ? (r >> 12) : 8;
        float4 xv[8]; float ss = 0.f;
#pragma unroll
        for (int i = 0; i < 8; ++i) xv[i] = *(const float4*)(src + (i * 64 + lane) * 4);
        if (mrow != cur) {
            cur = mrow;
            const float* sh = mod + (size_t)mrow * MODC + sidx * DM; const float* sc = sh + DM;
#pragma unroll
            for (int i = 0; i < 8; ++i) { s0[i] = *(const float4*)(sh + (i * 64 + lane) * 4); s1[i] = *(const float4*)(sc + (i * 64 + lane) * 4); }
        }
#pragma unroll
        for (int i = 0; i < 8; ++i) ss += xv[i].x * xv[i].x + xv[i].y * xv[i].y + xv[i].z * xv[i].z + xv[i].w * xv[i].w;
        ss = wave_sum(ss);
        const float inv = rsqrtf(ss * (1.0f / DM) + 1e-6f);
        u32x2 wv[8];
#pragma unroll
        for (int i = 0; i < 8; ++i) {
            const float o0 = xv[i].x * inv * g[i].x * (1.f + s1[i].x) + s0[i].x, o1 = xv[i].y * inv * g[i].y * (1.f + s1[i].y) + s0[i].y;
            const float o2 = xv[i].z * inv * g[i].z * (1.f + s1[i].z) + s0[i].z, o3 = xv[i].w * inv * g[i].w * (1.f + s1[i].w) + s0[i].w;
            wv[i].x = cvt_pk_bf16(o0, o1); wv[i].y = cvt_pk_bf16(o2, o3);
        }
#pragma unroll
        for (int i = 0; i < 8; ++i) *(u32x2*)(A + (size_t)r * DM + (i * 64 + lane) * 4) = wv[i];
    }
}

__device__ __forceinline__ void phase_final_norm(const Params& p) {
    const int tid = tid_opaque(); const int lane = tid & 63, gwv = blockIdx.x * 8 + (tid >> 6), nw = gridDim.x * 8;
    const float* gw = p.in[I_FNORM];
    const int per = (ML + nw - 1) / nw, r_lo = gwv * per, r_hi = (r_lo + per < ML) ? (r_lo + per) : ML;
    float4 g[8];
#pragma unroll
    for (int i = 0; i < 8; ++i) g[i] = *(const float4*)(gw + (i * 64 + lane) * 4);
    for (int r = r_lo; r < r_hi; ++r) {
        float* row = p.out + (size_t)r * DM;
        float4 xv[8]; float ss = 0.f;
#pragma unroll
        for (int i = 0; i < 8; ++i) xv[i] = *(const float4*)(row + (i * 64 + lane) * 4);
#pragma unroll
        for (int i = 0; i < 8; ++i) ss += xv[i].x * xv[i].x + xv[i].y * xv[i].y + xv[i].z * xv[i].z + xv[i].w * xv[i].w;
        ss = wave_sum(ss);
        const float inv = rsqrtf(ss * (1.0f / DM) + 1e-6f);
#pragma unroll
        for (int i = 0; i < 8; ++i)
            *(float4*)(row + (i * 64 + lane) * 4) = make_float4(xv[i].x * inv * g[i].x, xv[i].y * inv * g[i].y, xv[i].z * inv * g[i].z, xv[i].w * inv * g[i].w);
    }
}

__device__ __forceinline__ void phase_shortconv(const Params& p, unsigned char* shm, int t_start, int t_stride) {
    const int tid = tid_opaque();
    float* tile = (float*)shm;
    const bf16_t* PX = (const bf16_t*)(p.ws + WS_C);
    bf16_t* UT = (bf16_t*)(p.ws + WS_F);
    for (int t = t_start; t < NB * 64 * 12; t += t_stride) {
        const int cg4 = t % 12, gr = (t / 12) & 63, b = t / (12 * 64);
        {
            const int tt = tid >> 3, c8 = (tid & 7) * 8;
            u32x4 w[4];
#pragma unroll
            for (int q = 0; q < 4; ++q) w[q] = *(const u32x4*)(PX + (size_t)(b * SEQ + gr * 64 + tt) * INC + 5120 + (cg4 * 4 + q) * 64 + c8);
#pragma unroll
            for (int q = 0; q < 4; ++q) {
                float* tp = tile + q * (64 * 65) + tt * 65 + c8;
                tp[0] = bf_lo(w[q].x); tp[1] = bf_hi(w[q].x); tp[2] = bf_lo(w[q].y); tp[3] = bf_hi(w[q].y); tp[4] = bf_lo(w[q].z); tp[5] = bf_hi(w[q].z); tp[6] = bf_lo(w[q].w); tp[7] = bf_hi(w[q].w);
            }
        }
        __syncthreads();
#pragma unroll
        for (int q = 0; q < 4; ++q) {
            const int cc = tid >> 3, t8 = (tid & 7) * 8, ch = (cg4 * 4 + q) * 64 + cc;
            const float* tq = tile + q * (64 * 65);
            const float w0 = p.in[I_HCW][ch], w1 = p.in[I_HCW][3072 + ch], w2 = p.in[I_HCW][6144 + ch], bb = p.in[I_HCB][ch];
            float u[10];
#pragma unroll
            for (int j = 0; j < 10; ++j) { const int tt = t8 - 1 + j; u[j] = (tt >= 0 && tt < 64) ? tq[tt * 65 + cc] : 0.f; }
            float o[8];
#pragma unroll
            for (int j = 0; j < 8; ++j) o[j] = u[j] * w0 + u[j + 1] * w1 + u[j + 2] * w2 + bb;
            u32x4 w; w.x = cvt_pk_bf16(o[0], o[1]); w.y = cvt_pk_bf16(o[2], o[3]); w.z = cvt_pk_bf16(o[4], o[5]); w.w = cvt_pk_bf16(o[6], o[7]);
            *(u32x4*)(UT + ((size_t)(b * 3072 + ch)) * SEQ + gr * 64 + t8) = w;
        }
        __syncthreads();
    }
}

__device__ __forceinline__ int hg_row(int c, int s, int dir, int b) {
    if (c < 8) { const int q = c * 32 + s; return b * CTXL + (dir ? (CTXL - 1 - q) : q); }
    const int q = (c - 8) * 32 + s; return b * SEQ + (dir ? (SEQ - 1 - q) : q);
}
__device__ __forceinline__ void hgrn_item(const Params& p, int item, unsigned char* shm) {
    const int tid = tid_opaque(), w = tid >> 6, lane = tid & 63;
    const int dir = item & 1, vh = (item >> 1) & 1, h = (item >> 2) & 7, b = item >> 5;
    float* F = (float*)shm;
    float* Q = F + 32 * 128;
    float* V = Q + 32 * 128;
    float* OP = V + 32 * 64;
    const bf16_t* PX = (const bf16_t*)(p.ws + WS_C);
    const bf16_t* PXC = (const bf16_t*)(p.ws + WS_PXC);
    bf16_t* MIX = (bf16_t*)(p.ws + WS_ABUF);
    const int ls = tid >> 4, lk = (tid & 15) * 8;
    const int vs = (tid >> 3) & 31, v8 = (tid & 7) * 8;
    float lbv[8];
#pragma unroll
    for (int i = 0; i < 8; ++i) { const int j = h * 128 + lk + i; lbv[i] = sigmoidf_(p.in[I_LB][dir * 2048 + j] - p.in[I_LB][dir * 2048 + 1024 + j]); }
    f32x4 S4[4];
#pragma unroll
    for (int i = 0; i < 4; ++i) S4[i] = (f32x4){0.f, 0.f, 0.f, 0.f};
    const int vg4 = (lane >> 2) * 4, kq4 = (lane & 3) * 4;
    u32x4 rf, rq, rv;
    rq = (u32x4){0u, 0u, 0u, 0u}; rv = rq;
#if SKIP_CTX
    {
        const size_t ro = (size_t)hg_row(8, ls, dir, b) * INC;
        rf = *(const u32x4*)(PX + ro + dir * 1024 + h * 128 + lk);
        rq = *(const u32x4*)(PX + ro + 3072 + h * 128 + lk);
        if (tid < 256) rv = *(const u32x4*)(PX + (size_t)hg_row(8, vs, dir, b) * INC + 2048 + h * 128 + vh * 64 + v8);
    }
    for (int c = 8; c < 136; ++c) {
#else
    {
        const size_t ro = (size_t)hg_row(0, ls, dir, b) * 3072;
        rf = *(const u32x4*)(PXC + ro + dir * 1024 + h * 128 + lk);
        if (tid < 256) rv = *(const u32x4*)(PXC + (size_t)hg_row(0, vs, dir, b) * 3072 + 2048 + h * 128 + vh * 64 + v8);
    }
    for (int c = 0; c < 136; ++c) {
#endif
        const bool lat = c >= 8;
        __syncthreads();
        {
            float* fp = F + ls * 128 + lk;
            const float a0 = bf_lo(rf.x), a1 = bf_hi(rf.x), a2 = bf_lo(rf.y), a3 = bf_hi(rf.y), a4 = bf_lo(rf.z), a5 = bf_hi(rf.z), a6 = bf_lo(rf.w), a7 = bf_hi(rf.w);
            *(float4*)fp = make_float4(lbv[0] + (1.f - lbv[0]) * sigmoidf_(a0), lbv[1] + (1.f - lbv[1]) * sigmoidf_(a1), lbv[2] + (1.f - lbv[2]) * sigmoidf_(a2), lbv[3] + (1.f - lbv[3]) * sigmoidf_(a3));
            *(float4*)(fp + 4) = make_float4(lbv[4] + (1.f - lbv[4]) * sigmoidf_(a4), lbv[5] + (1.f - lbv[5]) * sigmoidf_(a5), lbv[6] + (1.f - lbv[6]) * sigmoidf_(a6), lbv[7] + (1.f - lbv[7]) * sigmoidf_(a7));
            if (lat) {
                const float qs = 0.08838834764831845f;
                float* qp = Q + ls * 128 + lk;
                *(float4*)qp = make_float4(bf_lo(rq.x) * qs, bf_hi(rq.x) * qs, bf_lo(rq.y) * qs, bf_hi(rq.y) * qs);
                *(float4*)(qp + 4) = make_float4(bf_lo(rq.z) * qs, bf_hi(rq.z) * qs, bf_lo(rq.w) * qs, bf_hi(rq.w) * qs);
            }
            if (tid < 256) {
                float* vp = V + vs * 64 + v8;
                *(float4*)vp = make_float4(bf_lo(rv.x), bf_hi(rv.x), bf_lo(rv.y), bf_hi(rv.y));
                *(float4*)(vp + 4) = make_float4(bf_lo(rv.z), bf_hi(rv.z), bf_lo(rv.w), bf_hi(rv.w));
            }
        }
        __syncthreads();
        if (c + 1 < 136) {
            const int cn = c + 1;
            if (cn < 8) {
                rf = *(const u32x4*)(PXC + (size_t)hg_row(cn, ls, dir, b) * 3072 + dir * 1024 + h * 128 + lk);
                if (tid < 256) rv = *(const u32x4*)(PXC + (size_t)hg_row(cn, vs, dir, b) * 3072 + 2048 + h * 128 + vh * 64 + v8);
            } else {
                const size_t ro = (size_t)hg_row(cn, ls, dir, b) * INC;
                rf = *(const u32x4*)(PX + ro + dir * 1024 + h * 128 + lk);
                rq = *(const u32x4*)(PX + ro + 3072 + h * 128 + lk);
                if (tid < 256) rv = *(const u32x4*)(PX + (size_t)hg_row(cn, vs, dir, b) * INC + 2048 + h * 128 + vh * 64 + v8);
            }
        }
        if (!lat) {
#pragma unroll 4
            for (int s = 0; s < 32; ++s) {
                const f32x4 v4 = *(const f32x4*)&V[s * 64 + vg4];
                const f32x4 f4 = *(const f32x4*)&F[s * 128 + w * 16 + kq4];
#pragma unroll
                for (int kk = 0; kk < 4; ++kk) {
                    const float fk = f4[kk];
                    const f32x4 t = v4 - fk * v4;
                    S4[kk] = fk * S4[kk] + t;
                }
            }
        } else {
#pragma unroll 4
            for (int s = 0; s < 32; ++s) {
                const f32x4 v4 = *(const f32x4*)&V[s * 64 + vg4];
                const f32x4 f4 = *(const f32x4*)&F[s * 128 + w * 16 + kq4];
                const f32x4 q4 = *(const f32x4*)&Q[s * 128 + w * 16 + kq4];
                f32x4 o = (f32x4){0.f, 0.f, 0.f, 0.f};
#pragma unroll
                for (int kk = 0; kk < 4; ++kk) {
                    const float fk = f4[kk];
                    const f32x4 t = v4 - fk * v4;
                    S4[kk] = fk * S4[kk] + t;
                    o += S4[kk] * q4[kk];
                }
#pragma unroll
                for (int j = 0; j < 4; ++j) {
                    float x = o[j];
                    x += __int_as_float(__builtin_amdgcn_update_dpp(0, __float_as_int(x), 0xB1, 0xf, 0xf, true));
                    x += __int_as_float(__builtin_amdgcn_update_dpp(0, __float_as_int(x), 0x4E, 0xf, 0xf, true));
                    o[j] = x;
                }
                if ((lane & 3) == 0) *(f32x4*)&OP[(w * 32 + s) * 64 + vg4] = o;
            }
            __syncthreads();
            {
                const int s = tid >> 4, v4 = (tid & 15) * 4;
                float4 a = *(const float4*)&OP[s * 64 + v4];
#pragma unroll
                for (int ww = 1; ww < 8; ++ww) { const float4 t = *(const float4*)&OP[(ww * 32 + s) * 64 + v4]; a.x += t.x; a.y += t.y; a.z += t.z; a.w += t.w; }
                u32x2 pk; pk.x = cvt_pk_bf16(a.x, a.y); pk.y = cvt_pk_bf16(a.z, a.w);
                *(u32x2*)(MIX + (size_t)hg_row(c, s, dir, b) * DM + dir * 1024 + h * 128 + vh * 64 + v4) = pk;
            }
        }
    }
    __syncthreads();
}


__device__ __forceinline__ int hg_row16(int c, int t, int dir, int b) {
    if (c < 16) { const int q = c * 16 + t; return b * CTXL + (dir ? (CTXL - 1 - q) : q); }
    const int q = (c - 16) * 16 + t; return b * SEQ + (dir ? (SEQ - 1 - q) : q);
}
__device__ __forceinline__ void hgrn_mfma_item(const Params& p, int item, unsigned char* shm) {
    const int tid = tid_opaque(), w = tid >> 6, lane = tid & 63, fr = lane & 15, fq = lane >> 4;
    const int dir = item & 1, h = (item >> 1) & 7, b = item >> 4;
    const bf16_t* PX = (const bf16_t*)(p.ws + WS_C);
    const bf16_t* PXC = (const bf16_t*)(p.ws + WS_PXC);
    bf16_t* MIX = (bf16_t*)(p.ws + WS_ABUF);
    const int kl = lane & 15, sq = lane >> 4, kcol = 16 * w + kl;
    const float lb = sigmoidf_(p.in[I_LB][dir * 2048 + h * 128 + kcol] - p.in[I_LB][dir * 2048 + 1024 + h * 128 + kcol]);
    f32x4 Sacc[8];
#pragma unroll
    for (int i = 0; i < 8; ++i) Sacc[i] = (f32x4){0.f, 0.f, 0.f, 0.f};
    bf16_t ra[4], rq[4], rv[4];
    const long sgn = dir ? -1 : 1;
    const bf16_t* pa[4]; const bf16_t* pv[4]; bf16_t* po[4];
#pragma unroll
    for (int j = 0; j < 4; ++j) {
        const long r0 = (long)b * CTXL + (dir ? CTXL - 1 : 0) + sgn * (4 * sq + j);
        pa[j] = PXC + r0 * 3072 + dir * 1024 + h * 128 + kcol; pv[j] = PXC + r0 * 3072 + 2048 + h * 128 + kcol;
        ra[j] = pa[j][0]; rv[j] = pv[j][0]; rq[j] = 0;
        po[j] = MIX + ((long)b * SEQ + (dir ? SEQ - 1 : 0) + sgn * (4 * fq + j)) * DM + dir * 1024 + h * 128 + 16 * w + fr;
    }
    for (int c = 0; c < 272; ++c) {
        const bool lat = c >= 16;
        unsigned char* sb = shm + (c & 1) * 36864;
        bf16_t* QT = (bf16_t*)(sb);
        bf16_t* KH = (bf16_t*)(sb + 4352);
        bf16_t* KTp = (bf16_t*)(sb + 8704);
        bf16_t* Vp = (bf16_t*)(sb + 13824);
        float* DEC = (float*)(sb + 18944);
        float kk[4], bt[4], qq[4], vv[4];
        {
            float run = 0.f;
#pragma unroll
            for (int j = 0; j < 4; ++j) {
                const float fj = lb + (1.f - lb) * sigmoidf_(bf2f(ra[j]));
                kk[j] = 1.f - fj; run += __logf(fj); bt[j] = run;
                qq[j] = bf2f(rq[j]) * 0.08838834764831845f; vv[j] = bf2f(rv[j]);
            }
            float x = run;
            const float y = __shfl_up(x, 16); if (sq >= 1) x += y;
            const float z = __shfl_up(x, 32); if (sq >= 2) x += z;
            const float excl = x - run;
            const float bend = __shfl(x, 48 + kl);
#pragma unroll
            for (int j = 0; j < 4; ++j) bt[j] += excl;
            if (c + 1 < 272) {
                const int cn = c + 1;
                if (cn == 16) {
#pragma unroll
                    for (int j = 0; j < 4; ++j) { const long r0 = (long)b * SEQ + (dir ? SEQ - 1 : 0) + sgn * (4 * sq + j);
                        pa[j] = PX + r0 * INC + dir * 1024 + h * 128 + kcol; pv[j] = PX + r0 * INC + 2048 + h * 128 + kcol; }
                } else {
                    const long st = sgn * 16 * (cn < 16 ? 3072 : INC);
#pragma unroll
                    for (int j = 0; j < 4; ++j) { pa[j] += st; pv[j] += st; }
                }
#pragma unroll
                for (int j = 0; j < 4; ++j) { ra[j] = pa[j][0]; rv[j] = pv[j][0]; if (cn >= 16) rq[j] = pv[j][1024]; }
            }
#pragma unroll
            for (int j = 0; j < 4; ++j) {
                const int st = 4 * sq + j;
                QT[st * 136 + kcol] = (bf16_t)(cvt_pk_safe(qq[j] * __expf(bt[j]), 0.f) & 0xffffu);
                KH[st * 136 + kcol] = (bf16_t)(cvt_pk_safe(kk[j] * __expf(-bt[j]), 0.f) & 0xffffu);
            }
            {
                u32x2 wk, wv;
                wk.x = cvt_pk_safe(kk[0] * __expf(bend - bt[0]), kk[1] * __expf(bend - bt[1])); wk.y = cvt_pk_safe(kk[2] * __expf(bend - bt[2]), kk[3] * __expf(bend - bt[3]));
                wv.x = cvt_pk_safe(vv[0], vv[1]); wv.y = cvt_pk_safe(vv[2], vv[3]);
                *(u32x2*)(KTp + kcol * 20 + 4 * sq) = wk;
                *(u32x2*)(Vp + kcol * 20 + 4 * sq) = wv;
            }
            if (sq == 3) DEC[kcol] = __expf(bend);
        }
        __syncthreads();
        u32x4 vbu; { const u32x2 t2 = *(const u32x2*)(Vp + (16 * w + fr) * 20 + 4 * fq); vbu.x = t2.x; vbu.y = t2.y; vbu.z = 0u; vbu.w = 0u; }
        const bf16x8 vb = __builtin_bit_cast(bf16x8, vbu);
        if (lat) {
            f32x4 at = (f32x4){0.f, 0.f, 0.f, 0.f};
#pragma unroll
            for (int ks = 0; ks < 4; ++ks) {
                const bf16x8 a = *(const bf16x8*)(KH + fr * 136 + ks * 32 + fq * 8);
                const bf16x8 bq = *(const bf16x8*)(QT + fr * 136 + ks * 32 + fq * 8);
                at = __builtin_amdgcn_mfma_f32_16x16x32_bf16(a, bq, at, 0, 0, 0);
            }
            asm volatile("s_nop 7\n\ts_nop 7" ::: "memory");
            u32x4 pau;
            {
                const float m0 = (4 * fq + 0 <= fr) ? at[0] : 0.f, m1 = (4 * fq + 1 <= fr) ? at[1] : 0.f, m2 = (4 * fq + 2 <= fr) ? at[2] : 0.f, m3 = (4 * fq + 3 <= fr) ? at[3] : 0.f;
                pau.x = cvt_pk_safe(m0, m1); pau.y = cvt_pk_safe(m2, m3); pau.z = 0u; pau.w = 0u;
            }
            f32x4 o = (f32x4){0.f, 0.f, 0.f, 0.f};
#pragma unroll
            for (int ks = 0; ks < 4; ++ks) {
                const u32x2 q0 = *(const u32x2*)(QT + fr * 136 + ks * 32 + 4 * fq), q1 = *(const u32x2*)(QT + fr * 136 + ks * 32 + 16 + 4 * fq);
                u32x4 au; au.x = q0.x; au.y = q0.y; au.z = q1.x; au.w = q1.y;
                u32x4 bu; bu.x = cvt_pk_safe(Sacc[2 * ks][0], Sacc[2 * ks][1]); bu.y = cvt_pk_safe(Sacc[2 * ks][2], Sacc[2 * ks][3]);
                bu.z = cvt_pk_safe(Sacc[2 * ks + 1][0], Sacc[2 * ks + 1][1]); bu.w = cvt_pk_safe(Sacc[2 * ks + 1][2], Sacc[2 * ks + 1][3]);
                o = __builtin_amdgcn_mfma_f32_16x16x32_bf16(__builtin_bit_cast(bf16x8, au), __builtin_bit_cast(bf16x8, bu), o, 0, 0, 0);
            }
            o = __builtin_amdgcn_mfma_f32_16x16x32_bf16(__builtin_bit_cast(bf16x8, pau), vb, o, 0, 0, 0);
#pragma unroll
            for (int r = 0; r < 4; ++r)
                { unsigned ub = __float_as_uint(o[r]); ub += 0x7fffu + ((ub >> 16) & 1u); po[r][0] = (bf16_t)(ub >> 16); po[r] += sgn * 16 * DM; }
        }
#pragma unroll
        for (int kt8 = 0; kt8 < 8; ++kt8) {
            const float4 d = *(const float4*)&DEC[16 * kt8 + 4 * fq];
            f32x4 sc = Sacc[kt8]; sc[0] *= d.x; sc[1] *= d.y; sc[2] *= d.z; sc[3] *= d.w;
            u32x4 au; { const u32x2 t2 = *(const u32x2*)(KTp + (16 * kt8 + fr) * 20 + 4 * fq); au.x = t2.x; au.y = t2.y; au.z = 0u; au.w = 0u; }
            Sacc[kt8] = __builtin_amdgcn_mfma_f32_16x16x32_bf16(__builtin_bit_cast(bf16x8, au), vb, sc, 0, 0, 0);
        }
    }
    __syncthreads();
}

__device__ __forceinline__ void hyena_item(const Params& p, int c, unsigned char* shm) {
    int tid = tid_opaque();
    float2* buf = (float2*)shm;
    float* wsm = (float*)(shm + FFT_LDS_ELEMS * 8);
    float* red = wsm + 256;
    bf16_t* UT = (bf16_t*)(p.ws + WS_F);
    const float* hid3T = (const float*)(p.ws + WS_HID3);
    __syncthreads();
    if (tid < 256) { const int j = tid >> 2, q = tid & 3; wsm[tid] = p.in[I_FWO][j * 4096 + q * 1024 + c]; }
    __syncthreads();
    const float dlo = -3.0701134573253945f, dhi = -15.350567286626972f;
    const float delta = fabsf(dlo + (float)c * ((dhi - dlo) / 1023.0f));
    float g0[16], g1[16];
    float l0 = 0.f, l1 = 0.f;
    {
        const float* hp[16];
#pragma unroll
        for (int m = 0; m < 16; ++m) {
            const int idx = tid + 512 * m;
            int lag = (m < 8) ? idx : (8192 - idx);
            lag = (lag < 4096) ? lag : 4095;
            hp[m] = hid3T + lag;
            g0[m] = 0.f; g1[m] = 0.f;
        }
#pragma unroll 4
        for (int j = 0; j < 64; ++j) {
            const float4 wv = *(const float4*)&wsm[j * 4];
#pragma unroll
            for (int m = 0; m < 16; ++m) {
                const float hv = hp[m][j * 4096];
                g0[m] += hv * ((m < 8) ? wv.x : wv.y);
                g1[m] += hv * ((m < 8) ? wv.z : wv.w);
            }
        }
#pragma unroll
        for (int m = 0; m < 16; ++m) {
            const int idx = tid + 512 * m;
            const int lag = (m < 8) ? idx : (8192 - idx);
            const float win = (lag < 4096) ? __expf(-((float)lag * (1.0f / 4095.0f)) * delta) : 0.f;
            g0[m] *= win; g1[m] *= win;
            l0 += fabsf(g0[m]); l1 += fabsf(g1[m]);
        }
    }
    l0 = wave_sum(l0); l1 = wave_sum(l1);
    if ((tid & 63) == 0) { red[(tid >> 6) * 2] = l0; red[(tid >> 6) * 2 + 1] = l1; }
    __syncthreads();
    l0 = 0.f; l1 = 0.f;
#pragma unroll
    for (int i = 0; i < 8; ++i) { l0 += red[i * 2]; l1 += red[i * 2 + 1]; }
    const float d0 = p.in[I_HYD][c], d1 = p.in[I_HYD][1024 + c];
#pragma unroll 1
    for (int f = 0; f < 2; ++f) {
        float2 v[16], H[16];
        const float sc = 1.0f / ((f ? l1 : l0) * 8192.0f);
#pragma unroll
        for (int m = 0; m < 16; ++m) v[m] = make_float2((f ? g1[m] : g0[m]) * sc, 0.f);
        FFT_FWD_TO_PAIRS(v, buf, tid);
#pragma unroll
        for (int m = 0; m < 16; ++m) H[m] = v[m];
        __syncthreads();
        const float dd = f ? d1 : d0;
#pragma unroll 1
        for (int pr = 0; pr < 4; ++pr) {
            asm volatile("" : "+v"(tid));
            const int b0 = 2 * pr, b1 = b0 + 1;
            bf16_t* s0 = UT + ((size_t)(b0 * 3072 + (f ? 1024 : 0) + c)) * SEQ;
            bf16_t* s1 = UT + ((size_t)(b1 * 3072 + (f ? 1024 : 0) + c)) * SEQ;
            float in0[8], in1[8];
#pragma unroll
            for (int m = 0; m < 8; ++m) { in0[m] = bf2f(s0[tid + 512 * m]); in1[m] = bf2f(s1[tid + 512 * m]); v[m] = make_float2(in0[m], in1[m]); v[m + 8] = make_float2(0.f, 0.f); }
            FFT_FWD_TO_PAIRS(v, buf, tid);
#pragma unroll
            for (int m = 0; m < 16; ++m) v[m] = cmul(v[m], H[m]);
            bf16_t* x0 = UT + ((size_t)(b0 * 3072 + (f ? 2048 : 1024) + c)) * SEQ;
            bf16_t* x1 = UT + ((size_t)(b1 * 3072 + (f ? 2048 : 1024) + c)) * SEQ;
            bf16_t* o0 = f ? UT + ((size_t)(b0 * 3072 + c)) * SEQ : x0;
            bf16_t* o1 = f ? UT + ((size_t)(b1 * 3072 + c)) * SEQ : x1;
            bf16_t xm0[8], xm1[8];
#pragma unroll
            for (int m = 0; m < 8; ++m) { xm0[m] = x0[tid + 512 * m]; xm1[m] = x1[tid + 512 * m]; }
            FFT_INV_FROM_PAIRS(v, buf, tid);
            bf16_t ro0[8], ro1[8];
#pragma unroll
            for (int m = 0; m < 8; ++m) {
                ro0[m] = f2bf(bf2f(xm0[m]) * (v[m].x + dd * in0[m]));
                ro1[m] = f2bf(bf2f(xm1[m]) * (v[m].y + dd * in1[m]));
            }
#pragma unroll
            for (int m = 0; m < 8; ++m) { o0[tid + 512 * m] = ro0[m]; o1[tid + 512 * m] = ro1[m]; }
        }
    }
    __syncthreads();
}

__device__ __forceinline__ void phase_readout(const Params& p) {
    const int tid = tid_opaque(); const int lane = tid & 63, gwv = blockIdx.x * 8 + (tid >> 6), nw = gridDim.x * 8;
    bf16_t* MIX = (bf16_t*)(p.ws + WS_ABUF);
    const bf16_t* PX = (const bf16_t*)(p.ws + WS_C);
    const int col = (lane >> 3) * 128 + (lane & 7) * 16;
    float gain[16];
#pragma unroll
    for (int i = 0; i < 16; ++i) gain[i] = p.in[I_HGN][col + i];
    for (int r = gwv; r < ML; r += 2 * nw) {
        const int r2 = (r + nw < ML) ? (r + nw) : r;
        u32x4 la[2][2], lb[2][2], lg[2][2];
#pragma unroll
        for (int q = 0; q < 2; ++q) {
            const int rr = q ? r2 : r;
            const bf16_t* mp = MIX + (size_t)rr * DM + col; const bf16_t* gp = PX + (size_t)rr * INC + 4096 + col;
#pragma unroll
            for (int hh = 0; hh < 2; ++hh) { la[q][hh] = *(const u32x4*)(mp + hh * 8); lb[q][hh] = *(const u32x4*)(mp + 1024 + hh * 8); lg[q][hh] = *(const u32x4*)(gp + hh * 8); }
        }
        asm volatile("" ::: "memory");
#pragma unroll
        for (int q = 0; q < 2; ++q) {
            if (q == 1 && r2 == r) break;
            const int rr = q ? r2 : r;
            bf16_t* mp = MIX + (size_t)rr * DM + col;
            float o[16], g[16];
#pragma unroll
            for (int hh = 0; hh < 2; ++hh) {
                const u32x4 a = la[q][hh], bq = lb[q][hh], gg = lg[q][hh];
                o[hh * 8 + 0] = bf_lo(a.x) + bf_lo(bq.x); o[hh * 8 + 1] = bf_hi(a.x) + bf_hi(bq.x); o[hh * 8 + 2] = bf_lo(a.y) + bf_lo(bq.y); o[hh * 8 + 3] = bf_hi(a.y) + bf_hi(bq.y);
                o[hh * 8 + 4] = bf_lo(a.z) + bf_lo(bq.z); o[hh * 8 + 5] = bf_hi(a.z) + bf_hi(bq.z); o[hh * 8 + 6] = bf_lo(a.w) + bf_lo(bq.w); o[hh * 8 + 7] = bf_hi(a.w) + bf_hi(bq.w);
                g[hh * 8 + 0] = bf_lo(gg.x); g[hh * 8 + 1] = bf_hi(gg.x); g[hh * 8 + 2] = bf_lo(gg.y); g[hh * 8 + 3] = bf_hi(gg.y);
                g[hh * 8 + 4] = bf_lo(gg.z); g[hh * 8 + 5] = bf_hi(gg.z); g[hh * 8 + 6] = bf_lo(gg.w); g[hh * 8 + 7] = bf_hi(gg.w);
            }
            float ss = 0.f;
#pragma unroll
            for (int i = 0; i < 16; ++i) ss += o[i] * o[i];
            ss += __shfl_xor(ss, 1); ss += __shfl_xor(ss, 2); ss += __shfl_xor(ss, 4);
            const float inv = rsqrtf(ss * (1.0f / 128.0f) + 1e-6f);
            float res[16];
#pragma unroll
            for (int i = 0; i < 16; ++i) res[i] = HG_SCALE * o[i] * inv * gain[i] * siluf_(g[i]);
#pragma unroll
            for (int hh = 0; hh < 2; ++hh) {
                u32x4 w; w.x = cvt_pk_bf16(res[hh * 8 + 0], res[hh * 8 + 1]); w.y = cvt_pk_bf16(res[hh * 8 + 2], res[hh * 8 + 3]); w.z = cvt_pk_bf16(res[hh * 8 + 4], res[hh * 8 + 5]); w.w = cvt_pk_bf16(res[hh * 8 + 6], res[hh * 8 + 7]);
                *(u32x4*)(mp + hh * 8) = w;
            }
        }
    }
}

__device__ __forceinline__ void phase_ytrans(const Params& p, unsigned char* shm) {
    const int tid = tid_opaque();
    float* tile = (float*)shm;
    const bf16_t* UT = (const bf16_t*)(p.ws + WS_F);
    bf16_t* MIX = (bf16_t*)(p.ws + WS_ABUF);
    for (int t = blockIdx.x; t < NB * 64 * 4; t += gridDim.x) {
        const int cg4 = t & 3, tb = (t >> 2) & 63, b = t >> 8;
        {
            const int cc = tid >> 3, t8 = (tid & 7) * 8;
            u32x4 w[4];
#pragma unroll
            for (int q = 0; q < 4; ++q) w[q] = *(const u32x4*)(UT + ((size_t)(b * 3072 + (cg4 * 4 + q) * 64 + cc)) * SEQ + tb * 64 + t8);
#pragma unroll
            for (int q = 0; q < 4; ++q) {
                float* tp = tile + q * (64 * 65) + cc * 65 + t8;
                tp[0] = bf_lo(w[q].x); tp[1] = bf_hi(w[q].x); tp[2] = bf_lo(w[q].y); tp[3] = bf_hi(w[q].y); tp[4] = bf_lo(w[q].z); tp[5] = bf_hi(w[q].z); tp[6] = bf_lo(w[q].w); tp[7] = bf_hi(w[q].w);
            }
        }
        __syncthreads();
#pragma unroll
        for (int q = 0; q < 4; ++q) {
            const int tt = tid >> 3, c8 = (tid & 7) * 8;
            const float* tq = tile + q * (64 * 65);
            float e[8];
#pragma unroll
            for (int j = 0; j < 8; ++j) e[j] = tq[(c8 + j) * 65 + tt];
            u32x4 w; w.x = cvt_pk_bf16(e[0], e[1]); w.y = cvt_pk_bf16(e[2], e[3]); w.z = cvt_pk_bf16(e[4], e[5]); w.w = cvt_pk_bf16(e[6], e[7]);
            *(u32x4*)(MIX + (size_t)(b * SEQ + tb * 64 + tt) * DM + 1024 + (cg4 * 4 + q) * 64 + c8) = w;
        }
        __syncthreads();
    }
}


#if DEBUG_CHECK
constexpr size_t WS_DBG = WS_END;
__device__ __forceinline__ float rbf(float x) { return bf2f(f2bf(x)); }
__device__ __forceinline__ void dbg_max(const Params& p, int slot, float e) { atomicMax((unsigned*)(p.ws + WS_DBG) + slot, __float_as_uint(e)); }
__device__ __forceinline__ unsigned hsh(unsigned x) { x ^= x >> 16; x *= 0x7feb352du; x ^= x >> 15; x *= 0x846ca68bu; x ^= x >> 16; return x; }
__device__ __forceinline__ float relerr(float got, float ref, float abs_floor) { return fabsf(got - ref) / (fabsf(ref) + abs_floor); }
__device__ __forceinline__ float naive_norm_elem(const float* src, const float* gw, const float* modrow, int sidx, int col) {
    float ss = 0.f; for (int k = 0; k < DM; ++k) ss += src[k] * src[k];
    const float inv = rsqrtf(ss / DM + 1e-6f);
    return src[col] * inv * gw[col] * (1.f + modrow[(sidx + 1) * DM + col]) + modrow[sidx * DM + col];
}
__device__ __forceinline__ void gemm_checks(const Params& p, int which) {
    const unsigned sid = blockIdx.x * 512 + threadIdx.x;
    const unsigned h1 = hsh(sid * 2u + 1u), h2 = hsh(sid * 2u + 2u);
    const float* mod = (const float*)(p.ws + WS_MOD);
    const bf16_t* ABUF = (const bf16_t*)(p.ws + WS_ABUF);
    const bf16_t* CB = (const bf16_t*)(p.ws + WS_C);
    const float* X1C = (const float*)(p.ws + WS_X1C);
    if (which == 1) {
        const int j = h1 % 9, col = h2 % MODC;
        float a = p.in[I_ADAB][col];
        for (int k = 0; k < DM; ++k) { const float cv = (j < 8) ? p.in[I_C][j * DM + k] : p.in[I_CCTX][k]; a += (cv / (1.f + expf(-cv))) * p.in[I_ADAW][(size_t)k * MODC + col]; }
        dbg_max(p, 0, relerr(mod[(size_t)j * MODC + col], a, 0.02f));
    } else if (which == 2 || which == 5 || which == 11) {
        const int nrows = (which == 11) ? ML : MT;
        const int row = h1 % nrows, col = h2 % DM;
        const float* src; const float* gw; int sidx;
        if (which == 2) { src = (row < ML) ? p.in[I_X] + (size_t)row * DM : p.in[I_CTX] + (size_t)(row - ML) * DM; gw = p.in[I_NFFN1]; sidx = 0; }
        else if (which == 5) { src = (row < ML) ? p.out + (size_t)row * DM : X1C + (size_t)(row - ML) * DM; gw = p.in[I_NMIX]; sidx = 3; }
        else { src = p.out + (size_t)row * DM; gw = p.in[I_NFFN2]; sidx = 6; }
        const float* modrow = mod + (size_t)((row < ML) ? (row >> 12) : 8) * MODC;
        const float ref = naive_norm_elem(src, gw, modrow, sidx, col);
        dbg_max(p, (which == 2) ? 1 : (which == 5) ? 4 : 7, relerr(bf2f(ABUF[(size_t)row * DM + col]), ref, 0.05f));
    } else if (which == 3 || which == 12) {
        const int nrows = (which == 12) ? ML : MT;
        const int row = h1 % nrows, hc = h2 % DFF;
        const float* w1 = p.in[(which == 3) ? I_F1W1 : I_F2W1]; const float* w3 = p.in[(which == 3) ? I_F1W3 : I_F2W3];
        float g = 0.f, u = 0.f;
        for (int k = 0; k < DM; ++k) { const float a = bf2f(ABUF[(size_t)row * DM + k]); g += a * rbf(w1[(size_t)k * DFF + hc]); u += a * rbf(w3[(size_t)k * DFF + hc]); }
        const float ref = (g / (1.f + expf(-g))) * u;
        dbg_max(p, (which == 3) ? 2 : 8, relerr(bf2f(CB[(size_t)row * DFF + hc]), ref, 0.05f));
    } else if (which == 4) {
        const int row = h1 % MT, col = h2 % DM;
        float d = 0.f;
        for (int k = 0; k < DFF; ++k) d += bf2f(CB[(size_t)row * DFF + k]) * rbf(p.in[I_F1W2][(size_t)k * DM + col]);
        const float src = (row < ML) ? p.in[I_X][(size_t)row * DM + col] : p.in[I_CTX][(size_t)(row - ML) * DM + col];
        const float gt = mod[(size_t)((row < ML) ? (row >> 12) : 8) * MODC + 2 * DM + col];
        const float ref = src + 0.5f * gt * d;
        const float got = (row < ML) ? p.out[(size_t)row * DM + col] : X1C[(size_t)(row - ML) * DM + col];
        dbg_max(p, 3, relerr(got, ref, 0.05f));
    } else if (which == 6) {
        const bool isc = (sid & 15) == 0;
        const int row = isc ? ML + (h1 % MC) : (h1 % ML), col = isc ? (h2 % 3072) : (h2 % INC);
        float d = 0.f;
        for (int k = 0; k < DM; ++k) d += bf2f(ABUF[(size_t)row * DM + k]) * rbf(p.in[I_WIN][(size_t)k * INC + col]);
        const float got = isc ? bf2f(((const bf16_t*)(p.ws + WS_PXC))[(size_t)(row - ML) * 3072 + col]) : bf2f(CB[(size_t)row * INC + col]);
        dbg_max(p, isc ? 6 : 5, relerr(got, d, 0.05f));
    }
}
#endif

#if ROWCHK
__device__ __forceinline__ float blk_max(float v, float* red) {
    const int tid = threadIdx.x;
    __syncthreads(); red[tid] = v; __syncthreads();
    float m = 0.f; for (int i = 0; i < 512; ++i) m = fmaxf(m, red[i]);
    __syncthreads();
    return m;
}
__device__ __forceinline__ float blk_sum(float v, float* red) {
    const int tid = threadIdx.x;
    __syncthreads(); red[tid] = v; __syncthreads();
    float m = 0.f; for (int i = 0; i < 512; ++i) m += red[i];
    __syncthreads();
    return m;
}
__device__ __forceinline__ void rc_norm(const float* src, const float* gw, const float* modb, int sidx, float* hrow, float* red) {
    const int tid = threadIdx.x;
    float ss = 0.f; for (int c = tid; c < DM; c += 512) ss += src[c] * src[c];
    __syncthreads(); red[tid] = ss; __syncthreads();
    float t = 0.f; for (int i = 0; i < 512; ++i) t += red[i];
    const float inv = 1.0f / sqrtf(t / DM + 1e-6f);
    for (int c = tid; c < DM; c += 512) hrow[c] = src[c] * inv * gw[c] * (1.f + modb[(sidx + 1) * DM + c]) + modb[sidx * DM + c];
    __syncthreads();
}
__device__ __forceinline__ void rc_ffn(const float* hrow, float* hid, const float* w1, const float* w3) {
    const int tid = threadIdx.x;
    for (int j = tid; j < DFF; j += 512) {
        float g = 0.f, u = 0.f;
        for (int k = 0; k < DM; ++k) { g += hrow[k] * w1[(size_t)k * DFF + j]; u += hrow[k] * w3[(size_t)k * DFF + j]; }
        hid[j] = (g / (1.f + expf(-g))) * u;
    }
    __syncthreads();
}
__device__ __forceinline__ void row_checks(const Params& p, int which, unsigned char* shm) {
    float* hrow = (float*)shm; float* hid = hrow + 2048; float* red = hid + 5632;
    const int tid = threadIdx.x, bid = blockIdx.x;
    const int row = bid * 128 + ((bid * 37) & 127);
    const float* modb = (const float*)(p.ws + WS_MOD) + (size_t)(row >> 12) * MODC;
    float* dbg = (float*)(p.ws + WS_MODP);
    float* save = dbg + 4096 + (size_t)bid * 2048;
    float e = 0.f, r2 = 0.f;
    if (which == 0 && bid >= 999) {
        const int rc = (bid - 192) * 32 + 7;
        const float* modc = (const float*)(p.ws + WS_MOD) + (size_t)8 * MODC;
        const float* X1Cc = (const float*)(p.ws + WS_X1C);
        rc_norm(p.in[I_CTX] + (size_t)rc * DM, p.in[I_NFFN1], modc, 0, hrow, red);
        rc_ffn(hrow, hid, p.in[I_F1W1], p.in[I_F1W3]);
        for (int c = tid; c < DM; c += 512) { float d = 0.f; for (int j = 0; j < DFF; ++j) d += hid[j] * p.in[I_F1W2][(size_t)j * DM + c];
            const float ref = p.in[I_CTX][(size_t)rc * DM + c] + 0.5f * modc[2 * DM + c] * d; { const float df = X1Cc[(size_t)rc * DM + c] - ref; e += df * df; r2 += ref * ref; } }
        e = blk_sum(e, red); r2 = blk_sum(r2, red); if (tid == 0) { dbg[5 * 256 + bid] = e; dbg[2048 + 5 * 256 + bid] = r2; }
    } else if (which == 1 && bid >= 999) {
        const int rc = (bid - 192) * 32 + 7;
        const float* modc = (const float*)(p.ws + WS_MOD) + (size_t)8 * MODC;
        rc_norm((const float*)(p.ws + WS_X1C) + (size_t)rc * DM, p.in[I_NMIX], modc, 3, hrow, red);
        const bf16_t* PXCc = (const bf16_t*)(p.ws + WS_PXC);
        for (int c = tid; c < 3072; c += 512) { float d = 0.f; for (int k = 0; k < DM; ++k) d += hrow[k] * p.in[I_WIN][(size_t)k * INC + c];
            { const float df = bf2f(PXCc[(size_t)rc * 3072 + c]) - d; e += df * df; r2 += d * d; } }
        e = blk_sum(e, red); r2 = blk_sum(r2, red); if (tid == 0) { dbg[7 * 256 + bid] = e; dbg[2048 + 7 * 256 + bid] = r2; }
    } else if (which == 0) {
        rc_norm(p.in[I_X] + (size_t)row * DM, p.in[I_NFFN1], modb, 0, hrow, red);
        rc_ffn(hrow, hid, p.in[I_F1W1], p.in[I_F1W3]);
        for (int c = tid; c < DM; c += 512) { float d = 0.f; for (int j = 0; j < DFF; ++j) d += hid[j] * p.in[I_F1W2][(size_t)j * DM + c];
            const float ref = p.in[I_X][(size_t)row * DM + c] + 0.5f * modb[2 * DM + c] * d; { const float df = p.out[(size_t)row * DM + c] - ref; e += df * df; r2 += ref * ref; } }
        e = blk_sum(e, red); r2 = blk_sum(r2, red); if (tid == 0) { dbg[0 * 256 + bid] = e; dbg[2048 + 0 * 256 + bid] = r2; }
    } else if (which == 1) {
        rc_norm(p.out + (size_t)row * DM, p.in[I_NMIX], modb, 3, hrow, red);
        const bf16_t* PX = (const bf16_t*)(p.ws + WS_C);
        for (int c = tid; c < INC; c += 512) { float d = 0.f; for (int k = 0; k < DM; ++k) d += hrow[k] * p.in[I_WIN][(size_t)k * INC + c];
            { const float df = bf2f(PX[(size_t)row * INC + c]) - d; e += df * df; r2 += d * d; } }
        e = blk_sum(e, red); r2 = blk_sum(r2, red); if (tid == 0) { dbg[1 * 256 + bid] = e; dbg[2048 + 1 * 256 + bid] = r2; }
    } else if (which == 2) {
        const bf16_t* MIX = (const bf16_t*)(p.ws + WS_ABUF);
        for (int c = tid; c < DM; c += 512) { float d = 0.f; for (int k = 0; k < DM; ++k) d += bf2f(MIX[(size_t)row * DM + k]) * p.in[I_WOUT][(size_t)k * DM + c];
            save[c] = p.out[(size_t)row * DM + c] + modb[5 * DM + c] * d; }
    } else if (which == 3) {
        for (int c = tid; c < DM; c += 512) { const float df = p.out[(size_t)row * DM + c] - save[c]; e += df * df; r2 += save[c] * save[c]; }
        e = blk_sum(e, red); r2 = blk_sum(r2, red); if (tid == 0) { dbg[2 * 256 + bid] = e; dbg[2048 + 2 * 256 + bid] = r2; }
        rc_norm(p.out + (size_t)row * DM, p.in[I_NFFN2], modb, 6, hrow, red);
        rc_ffn(hrow, hid, p.in[I_F2W1], p.in[I_F2W3]);
        for (int c = tid; c < DM; c += 512) { float d = 0.f; for (int j = 0; j < DFF; ++j) d += hid[j] * p.in[I_F2W2][(size_t)j * DM + c];
            save[c] = p.out[(size_t)row * DM + c] + 0.5f * modb[8 * DM + c] * d; }
    } else if (which == 4) {
        for (int c = tid; c < DM; c += 512) { const float df = p.out[(size_t)row * DM + c] - save[c]; e += df * df; r2 += save[c] * save[c]; }
        e = blk_sum(e, red); r2 = blk_sum(r2, red); if (tid == 0) { dbg[3 * 256 + bid] = e; dbg[2048 + 3 * 256 + bid] = r2; }
        float ss = 0.f; for (int c = tid; c < DM; c += 512) ss += p.out[(size_t)row * DM + c] * p.out[(size_t)row * DM + c];
        __syncthreads(); red[tid] = ss; __syncthreads();
        float t = 0.f; for (int i = 0; i < 512; ++i) t += red[i];
        const float inv = 1.0f / sqrtf(t / DM + 1e-6f);
        for (int c = tid; c < DM; c += 512) save[c] = p.out[(size_t)row * DM + c] * inv * p.in[I_FNORM][c];
    } else if (which == 5) {
        for (int c = tid; c < DM; c += 512) { const float df = p.out[(size_t)row * DM + c] - save[c]; e += df * df; r2 += save[c] * save[c]; }
        e = blk_sum(e, red); r2 = blk_sum(r2, red); if (tid == 0) { dbg[4 * 256 + bid] = e; dbg[2048 + 4 * 256 + bid] = r2; }
    } else if (which == 10) {
        const bf16_t* PX = (const bf16_t*)(p.ws + WS_C); const bf16_t* PXC = (const bf16_t*)(p.ws + WS_PXC); const bf16_t* MIX = (const bf16_t*)(p.ws + WS_ABUF);
        float* SL = (float*)shm;
        float* lbs = SL + 128 * 64;
        const int b = bid & 7, h = (bid >> 3) & 7, dir = (bid >> 6) & 1, v = (bid >> 7) * 64 + (tid & 63);
        if (tid < 128) { const int j = h * 128 + tid; lbs[tid] = sigmoidf_(p.in[I_LB][dir * 2048 + j] - p.in[I_LB][dir * 2048 + 1024 + j]); }
        __syncthreads();
        if (tid < 64) {
            for (int k = 0; k < 128; ++k) SL[k * 64 + tid] = 0.f;
            for (int step = 0; step < CTXL + SEQ; ++step) {
                const bool lat = step >= CTXL;
                const int q = lat ? step - CTXL : step;
                const bf16_t* rowp; int rw;
                if (!lat) { rw = b * CTXL + (dir ? CTXL - 1 - q : q); rowp = PXC + (size_t)rw * 3072; }
                else { rw = b * SEQ + (dir ? SEQ - 1 - q : q); rowp = PX + (size_t)rw * INC; }
                const float vv = bf2f(rowp[2048 + h * 128 + v]);
                float o = 0.f;
#pragma unroll 4
                for (int k = 0; k < 128; ++k) {
                    const float f = lbs[k] + (1.f - lbs[k]) * sigmoidf_(bf2f(rowp[dir * 1024 + h * 128 + k]));
                    const float sn = f * SL[k * 64 + tid] + (1.f - f) * vv;
                    SL[k * 64 + tid] = sn;
                    if (lat) o += sn * bf2f(rowp[3072 + h * 128 + k]) * 0.08838834764831845f;
                }
                if (lat) { const float got = bf2f(MIX[(size_t)rw * DM + dir * 1024 + h * 128 + v]); const float df = got - o; e += df * df; r2 += o * o; }
            }
        }
        e = blk_sum(e, red + 8192); r2 = blk_sum(r2, red + 8192); if (tid == 0) { dbg[528384 + bid] = e; dbg[528640 + bid] = r2; }
    } else if (which == 8) {
        const bf16_t* MIX = (const bf16_t*)(p.ws + WS_ABUF); const bf16_t* PX = (const bf16_t*)(p.ws + WS_C);
        for (int c = tid; c < 1024; c += 512) hrow[c] = bf2f(MIX[(size_t)row * DM + c]) + bf2f(MIX[(size_t)row * DM + 1024 + c]);
        __syncthreads();
        for (int c = tid; c < 1024; c += 512) { const int h0 = c & ~127; float ss = 0.f; for (int k = 0; k < 128; ++k) ss += hrow[h0 + k] * hrow[h0 + k];
            const float g = bf2f(PX[(size_t)row * INC + 4096 + c]);
            save[c] = hrow[c] / sqrtf(ss / 128.f + 1e-6f) * p.in[I_HGN][c] * (g / (1.f + expf(-g))); }
    } else if (which == 9) {
        const bf16_t* MIX = (const bf16_t*)(p.ws + WS_ABUF);
        for (int c = tid; c < 1024; c += 512) { const float df = bf2f(MIX[(size_t)row * DM + c]) - save[c]; e += df * df; r2 += save[c] * save[c]; }
        e = blk_sum(e, red); r2 = blk_sum(r2, red); if (tid == 0) { dbg[6 * 256 + bid] = e; dbg[2048 + 6 * 256 + bid] = r2; }
    } else if (which == 6) {
        if (bid == 0 && tid == 0) { float code = 0.f; for (int i = 0; i < 8; ++i) { float se = 0.f, sr = 0.f; for (int j = 0; j < 256; ++j) { const bool use = (i != 5 && i != 7); if (use) { se += dbg[i * 256 + j]; sr += dbg[2048 + i * 256 + j]; } } if (se > ROWCHK_TOL * sr) code += (float)(1 << i); } { for (int j = 0; j < 256; ++j) if (false && dbg[528384 + j] / (dbg[528640 + j] + 1e-20f) > HGCHK_TOL) code += 1.f; } p.out[0] += 10.f * code; }
    }
}
#endif

__global__ __launch_bounds__(512, 2) void mega(Params p) {
    extern __shared__ __attribute__((aligned(16))) unsigned char shm[];
    cg::grid_group grid = cg::this_grid();
    const int G = gridDim.x, bid = blockIdx.x;
    LAS unsigned char* lds = (LAS unsigned char*)shm;
    float* mod = (float*)(p.ws + WS_MOD);
    bf16_t* ABUF = (bf16_t*)(p.ws + WS_ABUF);
    bf16_t* CB = (bf16_t*)(p.ws + WS_C);
    float* X1C = (float*)(p.ws + WS_X1C);
    const bool split_ctx = (G >= 128) && (p.ph_lo == 0) && (p.ph_hi == NPH);
#if ROWCHK
    if (p.ph_lo >= 300) { row_checks(p, p.ph_lo - 300, shm); return; }
#endif
#if DEBUG_CHECK
    if (p.ph_lo >= 100 && p.ph_lo < 200) { gemm_checks(p, p.ph_lo - 100); return; }
    if (p.ph_lo == 200) {
        if (blockIdx.x == 0 && threadIdx.x == 0) { const float* d = (const float*)(p.ws + WS_DBG); float code = 0.f; for (int i = 0; i < 9; ++i) if (d[i] > 0.03f) code += (float)(1 << i); p.out[0] += 10.f * code; }
        return;
    }
#endif
#if DEBUG_CHECK
        if (p.ph_lo == 0 && blockIdx.x == 0 && threadIdx.x < 16) ((unsigned*)(p.ws + WS_DBG))[threadIdx.x] = 0u;
#endif
    unsigned long long tacc = 0ull, tprev = TSEL ? wall_clock64() : 0ull;
        PHASE_BEGIN(0) phase_prep(p, shm, split_ctx);
        PHASE_BEGIN(1) phase_modreduce(p);
        PHASE_BEGIN(2) phase_norm(p, p.in[I_X], p.in[I_CTX], 0, MT, p.in[I_NFFN1], 0, bid, G);
        PHASE_BEGIN(3) {
            pg8::Gemm g{ABUF, (const bf16_t*)(p.ws + WS_W13A), MT, 2 * DFF, DM};
            pg8::StaticOrder S; S.init(g.M, g.N, G, bid, 0);
            EpiSwiGLU E{CB};
            GEMM_RUN(3, g, S, E);
            if (split_ctx && G == 256 && bid >= 96) prep_tiles(p, shm, 8448, 10496, bid - 96, G - 96);
            else if (split_ctx && G != 256) prep_tiles(p, shm, 8448, 10496, bid, G);
        } PHASE_BEGIN(4) {
            pg8::Gemm g{CB, (const bf16_t*)(p.ws + WS_W2A), split_ctx ? ML : MT, DM, DFF};
            pg8::StaticOrder S; S.init(g.M, g.N, G, bid, 0);
            EpiRes E{p.in[I_X], p.out, p.in[I_CTX], X1C, mod + 2 * DM, 0.5f};
            GEMM_RUN(4, g, S, E);
        } PHASE_BEGIN(5) {
            if (!split_ctx) phase_norm(p, p.out, X1C, 0, MT, p.in[I_NMIX], 3, bid, G);
            else if (bid < 64) {
                pg8::Gemm g{CB + (size_t)ML * DFF, (const bf16_t*)(p.ws + WS_W2A), MC, DM, DFF};
                pg8::StaticOrder S; S.init(g.M, g.N, 64, bid, 0);
                EpiRes E{p.in[I_CTX], X1C, nullptr, nullptr, mod + 2 * DM, 0.5f, 8};
                GEMM_RUN(4, g, S, E);
            } else { phase_norm(p, p.out, X1C, 0, ML, p.in[I_NMIX], 3, bid - 64, G - 64); prep_tiles(p, shm, 19200, 22016, bid - 64, G - 64); }
        }
        PHASE_BEGIN(6) {
            if (split_ctx) { phase_norm(p, p.out, X1C, ML, MT, p.in[I_NMIX], 3, bid, G); grid.sync(); }
            pg8::Gemm g{ABUF, (const bf16_t*)(p.ws + WS_WIN), ML, INC, DM};
            pg8::StaticOrder S; S.init(g.M, g.N, G, bid, 96);
            EpiBf16 E{CB, INC, (bf16_t*)(p.ws + WS_PXC), 3072};
            GEMM_RUN(6, g, S, E);
            if (split_ctx && G == 256 && bid >= 96) prep_tiles(p, shm, 12544, 13568, bid - 96, G - 96);
            else if (split_ctx && G != 256) prep_tiles(p, shm, 12544, 13568, bid, G);
        } PHASE_BEGIN(7) {
#if HG_MFMA
            if (G >= 256) { if (bid < 128) hgrn_mfma_item(p, bid, shm); else { phase_shortconv(p, shm, bid - 128, G - 128); if (split_ctx) prep_tiles(p, shm, 13568, 19200, bid - 128, G - 128); } }
            else if (split_ctx) {   phase_shortconv(p, shm, bid, G); prep_tiles(p, shm, 13568, 19200, bid, G); for (int it = bid; it < 128; it += G) hgrn_mfma_item(p, it, shm); }
            else { phase_shortconv(p, shm, bid, G); for (int it = bid; it < 128; it += G) hgrn_mfma_item(p, it, shm); }
#else
            phase_shortconv(p, shm, bid, G);
            for (int it = bid; it < 256; it += G) hgrn_item(p, it, shm);
#endif
        } PHASE_BEGIN(8) {
            for (int c = bid; c < 1024; c += G) hyena_item(p, c, shm);
            phase_readout(p);
        } PHASE_BEGIN(9) phase_ytrans(p, shm);
        PHASE_BEGIN(10) {
            pg8::Gemm g{ABUF, (const bf16_t*)(p.ws + WS_WOUT), ML, DM, DM};
            pg8::StaticOrder S; S.init(g.M, g.N, G, bid, 0);
            EpiRes E{p.out, p.out, nullptr, nullptr, mod + 5 * DM, 1.0f};
            GEMM_RUN(10, g, S, E);
        } PHASE_BEGIN(11) phase_norm(p, p.out, nullptr, 0, ML, p.in[I_NFFN2], 6, bid, G);
        PHASE_BEGIN(12) {
            pg8::Gemm g{ABUF, (const bf16_t*)(p.ws + WS_W13B), ML, 2 * DFF, DM};
            pg8::StaticOrder S; S.init(g.M, g.N, G, bid, 0);
            EpiSwiGLU E{CB};
            GEMM_RUN(12, g, S, E);
        } PHASE_BEGIN(13) {
            pg8::Gemm g{CB, (const bf16_t*)(p.ws + WS_W2B), ML, DM, DFF};
            pg8::StaticOrder S; S.init(g.M, g.N, G, bid, 0);
            EpiRes E{p.out, p.out, nullptr, nullptr, mod + 8 * DM, 0.5f};
            GEMM_RUN(13, g, S, E);
        } PHASE_BEGIN(14) phase_final_norm(p);
    if (TSEL) { const unsigned long long now_ = wall_clock64(); if (TSEL & (1 << 14)) tacc += now_ - tprev; if (blockIdx.x == 0 && threadIdx.x == 0) p.out[4096 * 2048 + 5] += (float)tacc * 0.0001f; }
}

extern "C" void kernel_launch(void* const* d_in, const int* in_sizes, int n_in, void* d_out, int out_size, void* d_ws, size_t ws_size, hipStream_t stream) {
    static int grid_blocks = 0;
    if (grid_blocks == 0) {
        if (n_in != 31 || out_size != ML * DM || ws_size < WS_END + 64) { fprintf(stderr, "kernel_launch: unexpected shapes (n_in %d out %d ws %zu need %zu)\n", n_in, out_size, ws_size, (size_t)WS_END); grid_blocks = -1; return; }
        int dev = 0, cus = 0, per_cu = 0;
        hipGetDevice(&dev);
        hipDeviceGetAttribute(&cus, hipDeviceAttributeMultiprocessorCount, dev);
        if (hipFuncSetAttribute((const void*)mega, hipFuncAttributeMaxDynamicSharedMemorySize, LDS_BYTES) != hipSuccess) { fprintf(stderr, "kernel_launch: hipFuncSetAttribute failed\n"); grid_blocks = -1; return; }
        if (hipOccupancyMaxActiveBlocksPerMultiprocessor(&per_cu, (const void*)mega, 512, LDS_BYTES) != hipSuccess || per_cu < 1) { fprintf(stderr, "kernel_launch: occupancy query failed (%d)\n", per_cu); per_cu = 1; (void)hipGetLastError(); }
        grid_blocks = cus * per_cu;
    }
    if (grid_blocks < 0) return;
    Params p;
    memset(&p, 0, sizeof(p));
    for (int i = 0; i < 31; ++i) p.in[i] = (const float*)d_in[i];
    p.out = (float*)d_out; p.ws = (unsigned char*)d_ws;
#if MULTI_LAUNCH
    for (int ph = 0; ph < NPH; ++ph) {
        p.ph_lo = ph; p.ph_hi = ph + 1;
        hipLaunchKernelGGL(mega, dim3(grid_blocks), dim3(512), LDS_BYTES, stream, p);
#if ROWCHK
        { const int w = (ph == 4) ? 0 : (ph == 6) ? 1 : (ph == 7) ? 8 : (ph == 8) ? 9 : (ph == 9) ? 2 : (ph == 10) ? 3 : (ph == 13) ? 4 : (ph == 14) ? 5 : -1;
          if (w >= 0) { p.ph_lo = 300 + w; p.ph_hi = 301 + w; hipLaunchKernelGGL(mega, dim3(256), dim3(512), LDS_BYTES, stream, p); }
          if (ph == 7) { p.ph_lo = 310; p.ph_hi = 311; hipLaunchKernelGGL(mega, dim3(256), dim3(512), LDS_BYTES, stream, p); }
          if (ph == 14) { p.ph_lo = 306; p.ph_hi = 307; hipLaunchKernelGGL(mega, dim3(256), dim3(512), LDS_BYTES, stream, p); } }
#endif
#if DEBUG_CHECK
        if (DBG_MASK & (1 << ph)) { p.ph_lo = 100 + ph; p.ph_hi = 101 + ph; hipLaunchKernelGGL(mega, dim3(grid_blocks), dim3(512), LDS_BYTES, stream, p); }
        if (ph == NPH - 1) { p.ph_lo = 200; p.ph_hi = 201 + DBG_SLOT; hipLaunchKernelGGL(mega, dim3(grid_blocks), dim3(512), LDS_BYTES, stream, p); }
#endif
    }
#else
    p.ph_lo = 0; p.ph_hi = NPH;
    void* args[] = {&p};
    hipError_t e = hipLaunchCooperativeKernel((const void*)mega, dim3(grid_blocks), dim3(512), args, LDS_BYTES, stream);
    if (e != hipSuccess) fprintf(stderr, "cooperative launch failed: %s (grid %d)\n", hipGetErrorString(e), grid_blocks);
#endif
}
```

```cpp
#include <hip/hip_runtime.h>
#include <hip/hip_cooperative_groups.h>
#include <cstdio>
#include <cstring>
namespace cg = cooperative_groups;

#ifndef ONLY_PH
#define ONLY_PH -1
#endif
#define PH(n) (p.ph_lo <= (n) && (n) < p.ph_hi && (ONLY_PH < 0 || ONLY_PH == (n)))
#define PHASE_BEGIN(n) if (p.ph_lo < (n) && (n) < p.ph_hi) { grid.sync(); if (TSEL) { const unsigned long long now_ = wall_clock64(); if (TSEL & (1 << ((n) - 1))) tacc += now_ - tprev; tprev = now_; } } if (PH(n))
#ifndef HY_SCALE
#define HY_SCALE 1.0f
#endif
#ifndef HG_SCALE
#define HG_SCALE 1.0f
#endif
#ifndef SKIP_CTX
#define SKIP_CTX 0
#endif
#ifndef DEBUG_CHECK
#define DEBUG_CHECK 0
#endif
#ifndef DBG_SLOT
#define DBG_SLOT 0
#endif
#ifndef DBG_MASK
#define DBG_MASK 0x0
#endif
#ifndef SIMPLE_GEMM
#define SIMPLE_GEMM 0x0
#endif
#ifndef FN_NOGAIN
#define FN_NOGAIN 0
#endif
#ifndef ROWCHK
#define ROWCHK 0
#endif
#ifndef ROWCHK_TOL
#define ROWCHK_TOL 1e-5f
#endif
#ifndef HGCHK_TOL
#define HGCHK_TOL 1e-4f
#endif
#ifndef TSEL
#define TSEL 0
#endif
#ifndef HG_MFMA
#define HG_MFMA 1
#endif
#ifndef MULTI_LAUNCH
#define MULTI_LAUNCH 0
#endif

#define LAS __attribute__((address_space(3)))
typedef unsigned short bf16_t;
typedef short bf16x8 __attribute__((ext_vector_type(8)));
typedef float f32x4 __attribute__((ext_vector_type(4)));
typedef unsigned u32x4 __attribute__((ext_vector_type(4)));
typedef unsigned u32x2 __attribute__((ext_vector_type(2)));

constexpr int DM = 2048, NB = 8, SEQ = 4096, CTXL = 256, DFF = 5632, MODC = 18432, HGW = 1024, INC = 8192;
constexpr int ML = NB * SEQ, MC = NB * CTXL, MT = ML + MC;
constexpr int NPH = 15;
constexpr int LDS_BYTES = 131072;

constexpr size_t WS_WIN = 0;
constexpr size_t WS_WOUT = WS_WIN + (size_t)INC * DM * 2;
constexpr size_t WS_W13B = WS_WOUT + (size_t)DM * DM * 2;
constexpr size_t WS_W2B = WS_W13B + (size_t)2 * DFF * DM * 2;
constexpr size_t WS_MODP = WS_W2B + (size_t)DM * DFF * 2;
constexpr size_t WS_MOD = WS_MODP + (size_t)8 * 9 * MODC * 4;
constexpr size_t WS_HID3 = WS_MOD + (size_t)9 * MODC * 4;
constexpr size_t WS_X1C = WS_HID3 + (size_t)64 * 4096 * 4;
constexpr size_t WS_PXC = WS_X1C + (size_t)MC * DM * 4;
constexpr size_t WS_ABUF = WS_PXC + (size_t)MC * 3072 * 2;
constexpr size_t WS_C = WS_ABUF + (size_t)MT * DM * 2;
constexpr size_t WS_F = WS_C + (size_t)ML * INC * 2;
constexpr size_t WS_W13A = WS_F;
constexpr size_t WS_W2A = WS_W13A + (size_t)2 * DFF * DM * 2;
constexpr size_t WS_END = WS_F + (size_t)NB * 3072 * SEQ * 2;
static_assert((size_t)MT * DFF * 2 <= (size_t)ML * INC * 2, "H fits in region C");

struct Params {
    const float* in[31];
    float* out;
    unsigned char* ws;
    int ph_lo, ph_hi;
};
enum { I_X = 0, I_C, I_CTX, I_CCTX, I_ADAW, I_ADAB, I_NFFN1, I_F1W1, I_F1W3, I_F1W2, I_NMIX, I_WIN, I_LB, I_HGN, I_HCW, I_HCB, I_FW1, I_FB1, I_FW2, I_FB2, I_FW3, I_FB3, I_FFREQ, I_FWO, I_HYD, I_WOUT, I_NFFN2, I_F2W1, I_F2W3, I_F2W2, I_FNORM };

__device__ __forceinline__ unsigned cvt_pk_bf16(float lo, float hi) { unsigned r; asm volatile("v_cvt_pk_bf16_f32 %0, %1, %2" : "=v"(r) : "v"(lo), "v"(hi)); return r; }
typedef __bf16 bf16v2_t __attribute__((ext_vector_type(2)));
typedef float f32x2_t __attribute__((ext_vector_type(2)));
__device__ __forceinline__ unsigned cvt_pk_safe(float lo, float hi) { const f32x2_t v = {lo, hi}; const bf16v2_t b = __builtin_convertvector(v, bf16v2_t); return __builtin_bit_cast(unsigned, b); }
__device__ __forceinline__ float bf_lo(unsigned w) { return __uint_as_float(w << 16); }
__device__ __forceinline__ float bf_hi(unsigned w) { return __uint_as_float(w & 0xffff0000u); }
__device__ __forceinline__ float bf2f(bf16_t h) { return __uint_as_float(((unsigned)h) << 16); }
__device__ __forceinline__ bf16_t f2bf(float f) { return (bf16_t)(cvt_pk_bf16(f, 0.f) & 0xffffu); }
__device__ __forceinline__ float sigmoidf_(float x) { return __builtin_amdgcn_rcpf(1.0f + __expf(-x)); }
__device__ __forceinline__ float siluf_(float x) { return x * sigmoidf_(x); }
__device__ __forceinline__ int tid_opaque() { int t = threadIdx.x; asm volatile("" : "+v"(t)); return t; }
#define HW_COS(r) __builtin_amdgcn_cosf(r)
#define HW_SIN(r) __builtin_amdgcn_sinf(r)
#define SYNC() __syncthreads()
__device__ __forceinline__ float sin_rad(float a) { float r = a * 0.15915494309189535f; r -= rintf(r); return HW_SIN(r); }
__device__ __forceinline__ float cos_rad(float a) { float r = a * 0.15915494309189535f; r -= rintf(r); return HW_COS(r); }
__device__ __forceinline__ float wave_sum(float v) {
#pragma unroll
    for (int o = 32; o > 0; o >>= 1) v += __shfl_xor(v, o);
    return v;
}

#define FPAD(i) ((i) + (((i) >> 5) << 1))
#define FFT_LDS_ELEMS 8704
__device__ __forceinline__ float2 cadd(float2 a, float2 b) { return make_float2(a.x + b.x, a.y + b.y); }
__device__ __forceinline__ float2 csub(float2 a, float2 b) { return make_float2(a.x - b.x, a.y - b.y); }
__device__ __forceinline__ float2 cmul(float2 a, float2 b) { return make_float2(a.x * b.x - a.y * b.y, a.x * b.y + a.y * b.x); }
__device__ __forceinline__ float2 cmulc(float2 a, float2 b) { return make_float2(a.x * b.x + a.y * b.y, a.y * b.x - a.x * b.y); }
__device__ __forceinline__ float2 twid(float rev) { return make_float2(HW_COS(rev), -HW_SIN(rev)); }

template <int K> struct W16 {
    static constexpr float X = (K == 0) ? 1.f : (K == 1) ? 0.92387953251f : (K == 2) ? 0.70710678119f : (K == 3) ? 0.38268343237f : (K == 4) ? 0.f : (K == 5) ? -0.38268343237f : (K == 6) ? -0.70710678119f : -0.92387953251f;
    static constexpr float Y = (K == 0) ? 0.f : (K == 1) ? -0.38268343237f : (K == 2) ? -0.70710678119f : (K == 3) ? -0.92387953251f : (K == 4) ? -1.f : (K == 5) ? -0.92387953251f : (K == 6) ? -0.70710678119f : -0.38268343237f;
};

template <int U, int ML_, bool INV> __device__ __forceinline__ void fft_bfly_group(float2 (&v)[16], float2 Tu) {
    constexpr int half = 8 >> U;
    const float2 tw = (ML_ == 0) ? Tu : cmul(Tu, make_float2(W16<(ML_ << U)>::X, W16<(ML_ << U)>::Y));
#pragma unroll
    for (int bs = 0; bs < 16; bs += 2 * half) {
        const int m = bs + ML_;
        if (!INV) { const float2 a = v[m], b = v[m + half]; v[m] = cadd(a, b); v[m + half] = cmul(csub(a, b), tw); }
        else { const float2 a = v[m], b = cmulc(v[m + half], tw); v[m] = cadd(a, b); v[m + half] = csub(a, b); }
    }
}
template <int U, bool INV> __device__ __forceinline__ void fft_stage(float2 (&v)[16], float2 Tu) {
    constexpr int half = 8 >> U;
    fft_bfly_group<U, 0, INV>(v, Tu);
    if constexpr (half > 1) fft_bfly_group<U, 1, INV>(v, Tu);
    if constexpr (half > 2) { fft_bfly_group<U, 2, INV>(v, Tu); fft_bfly_group<U, 3, INV>(v, Tu); }
    if constexpr (half > 4) { fft_bfly_group<U, 4, INV>(v, Tu); fft_bfly_group<U, 5, INV>(v, Tu); fft_bfly_group<U, 6, INV>(v, Tu); fft_bfly_group<U, 7, INV>(v, Tu); }
}
template <int P, bool INV> __device__ __forceinline__ void fft16(float2 (&v)[16], int L) {
    const float sc = 1.0f / (float)(1 << (P + 4));
    const float2 T0 = twid((float)L * sc), T1 = twid((float)(L << 1) * sc), T2 = twid((float)(L << 2) * sc), T3 = twid((float)(L << 3) * sc);
    if (!INV) { fft_stage<0, false>(v, T0); fft_stage<1, false>(v, T1); fft_stage<2, false>(v, T2); fft_stage<3, false>(v, T3); }
    else { fft_stage<3, true>(v, T3); fft_stage<2, true>(v, T2); fft_stage<1, true>(v, T1); fft_stage<0, true>(v, T0); }
}
__device__ __forceinline__ int fidxA(int tid, int m) { return tid + 512 * m; }
__device__ __forceinline__ int fidxB(int tid, int m) { return ((tid >> 5) << 9) + (m << 5) + (tid & 31); }
__device__ __forceinline__ int fidxC(int tid, int m) { return ((tid >> 1) << 5) + (m << 1) + (tid & 1); }

#define FFT_FWD_TO_PAIRS(v, buf, tid_) do { int ftid = (tid_); asm volatile("" : "+v"(ftid)); \
    fft16<9, false>(v, ftid); \
    _Pragma("unroll") for (int m = 0; m < 16; ++m) buf[FPAD(fidxA(ftid, m))] = v[m]; \
    SYNC(); \
    _Pragma("unroll") for (int m = 0; m < 16; ++m) v[m] = buf[FPAD(fidxB(ftid, m))]; \
    fft16<5, false>(v, ftid & 31); \
    _Pragma("unroll") for (int m = 0; m < 16; ++m) buf[FPAD(fidxB(ftid, m))] = v[m]; \
    SYNC(); \
    _Pragma("unroll") for (int m = 0; m < 16; ++m) v[m] = buf[FPAD(fidxC(ftid, m))]; \
    fft16<1, false>(v, ftid & 1); \
    _Pragma("unroll") for (int m = 0; m < 16; ++m) buf[FPAD(fidxC(ftid, m))] = v[m]; \
    SYNC(); \
    _Pragma("unroll") for (int q = 0; q < 8; ++q) { const int j2 = 2 * (ftid + 512 * q); const float4 pr = *(const float4*)&buf[FPAD(j2)]; \
        v[2 * q] = make_float2(pr.x + pr.z, pr.y + pr.w); v[2 * q + 1] = make_float2(pr.x - pr.z, pr.y - pr.w); } \
} while (0)

#define FFT_INV_FROM_PAIRS(v, buf, tid_) do { int ftid = (tid_); asm volatile("" : "+v"(ftid)); \
    _Pragma("unroll") for (int q = 0; q < 8; ++q) { const int j2 = 2 * (ftid + 512 * q); const float2 a = v[2 * q], b = v[2 * q + 1]; \
        *(float4*)&buf[FPAD(j2)] = make_float4(a.x + b.x, a.y + b.y, a.x - b.x, a.y - b.y); } \
    SYNC(); \
    _Pragma("unroll") for (int m = 0; m < 16; ++m) v[m] = buf[FPAD(fidxC(ftid, m))]; \
    fft16<1, true>(v, ftid & 1); \
    _Pragma("unroll") for (int m = 0; m < 16; ++m) buf[FPAD(fidxC(ftid, m))] = v[m]; \
    SYNC(); \
    _Pragma("unroll") for (int m = 0; m < 16; ++m) v[m] = buf[FPAD(fidxB(ftid, m))]; \
    fft16<5, true>(v, ftid & 31); \
    _Pragma("unroll") for (int m = 0; m < 16; ++m) buf[FPAD(fidxB(ftid, m))] = v[m]; \
    SYNC(); \
    _Pragma("unroll") for (int m = 0; m < 16; ++m) v[m] = buf[FPAD(fidxA(ftid, m))]; \
    fft16<9, true>(v, ftid); \
} while (0)

namespace pg8 {
constexpr int BM = 256, BK = 64, HALF = 128, HTB = HALF * BK * 2, STAGE_BYTES = 8 * HTB, NXCD = 8, WGM = 4;
__device__ __forceinline__ int lds_byte(int r, int c) { const int st = (r >> 4) * 2 + (c >> 5), rr = r & 15, cc = c & 31, ob = rr * 64 + cc * 2; return st * 1024 + (ob ^ (((ob >> 9) & 1) << 5)); }
__device__ __forceinline__ void stage_rc(int b, int& R, int& C) { const int st = b / 1024, sb = b % 1024, swz = sb ^ (((sb >> 9) & 1) << 5); R = (st >> 1) * 16 + swz / 64; C = (st & 1) * 32 + (swz % 64) / 2; }
__device__ __forceinline__ int perm32(int rho) { const int n = rho >> 4, i = rho & 15; return 8 * (i >> 2) + 4 * n + (i & 3); }
struct Unit { int pm, pn; };
struct Gemm { const bf16_t* A; const bf16_t* Bt; int M, N, K; };
struct StaticOrder {
    int nM, nN, nwg, G, c, extra;
    __device__ void init(int M, int N, int G_, int c_, int extra_) { nM = M / BM; nN = N / BM; nwg = nM * nN; G = G_; c = c_; extra = extra_; }
    __device__ bool next(int i, Unit& u) const {
        const long L = (long)i * G + c;
        if (L >= nwg) { const int e = (int)(L - nwg); if (e >= extra) return false; u.pm = 128 + (e & 7); u.pn = e >> 3; return true; }
        int wgid = (int)L; { const int q = nwg / NXCD, r = nwg % NXCD, xcd = wgid % NXCD, off = wgid / NXCD; wgid = (xcd < r ? xcd * (q + 1) : r * (q + 1) + (xcd - r) * q) + off; }
        const int nig = WGM * nN, gid = wgid / nig, fm = gid * WGM, gsz = (nM - fm) < WGM ? (nM - fm) : WGM;
        u.pm = fm + ((wgid % nig) % gsz); u.pn = (wgid % nig) / gsz; return true;
    }
    __device__ __forceinline__ void a_ready(const Unit&) const {}
    __device__ __forceinline__ void done(const Unit&) const {}
};

template <class Epi, class Sched>
__device__ __forceinline__ void gemm_phase(LAS unsigned char* lds, const Gemm g, const Sched& S, const Epi& E) {
    const int tid = tid_opaque(), wid = __builtin_amdgcn_readfirstlane(tid >> 6), lane = tid & 63, wr = wid >> 2, wc = wid & 3, fr = lane & 15, fq = lane >> 4;
    const int K = g.K, nt = K / BK;
    unsigned voffA[2], voffB[2];
#pragma unroll
    for (int i = 0; i < 2; ++i) { int R, C; stage_rc(tid * 16 + i * 8192, R, C); const int Rb = Epi::PERM ? ((R & ~31) + perm32(R & 31)) : R;
        voffA[i] = (unsigned)(R * K + C) * 2u; voffB[i] = (unsigned)(Rb * K + C) * 2u; }
    const size_t kstep = (size_t)(BK * 2);
    const size_t hstep = (size_t)HALF * K * 2;
    const size_t tstep = 2 * hstep;
    const unsigned ldsw = (unsigned)wid * 1024u;
    const int aoff = lds_byte(wr * 64 + fr, fq * 8), boff = lds_byte(wc * 32 + fr, fq * 8);
#define PG8_SA(b, h) (((b) * 2 + (h)) * HTB)
#define PG8_SB(b, h) ((4 + (b) * 2 + (h)) * HTB)
#define PG8_STAGE(bufoff, gbase, voff) do { _Pragma("unroll") for (int _i = 0; _i < 2; ++_i) \
        __builtin_amdgcn_global_load_lds((const unsigned*)((const char*)(gbase) + (voff)[_i]), (LAS unsigned*)(lds + (bufoff) + ldsw + _i * 8192), 16, 0, 0); } while (0)
#define PG8_LDA(dst, b, h) do { _Pragma("unroll") for (int m = 0; m < 4; ++m) _Pragma("unroll") for (int k = 0; k < 2; ++k) dst[m][k] = *(const LAS bf16x8*)(lds + PG8_SA(b, h) + aoff + m * 2048 + k * 1024); } while (0)
#define PG8_LDB(dst, b, h) do { _Pragma("unroll") for (int n = 0; n < 2; ++n) _Pragma("unroll") for (int k = 0; k < 2; ++k) dst[n][k] = *(const LAS bf16x8*)(lds + PG8_SB(b, h) + boff + n * 2048 + k * 1024); } while (0)
#define PG8_MMA(ai, bj, At, Bt) do { __builtin_amdgcn_s_setprio(1); _Pragma("unroll") for (int m = 0; m < 4; ++m) _Pragma("unroll") for (int n = 0; n < 2; ++n) _Pragma("unroll") for (int k = 0; k < 2; ++k) \
        acc[ai][bj][m][n] = __builtin_amdgcn_mfma_f32_16x16x32_bf16(Bt[n][k], At[m][k], acc[ai][bj][m][n], 0, 0, 0); __builtin_amdgcn_s_setprio(0); } while (0)
#define PG8_WAIT_V(n) asm volatile("s_waitcnt vmcnt(" #n ")" ::: "memory")
#define PG8_WAIT_L(n) asm volatile("s_waitcnt lgkmcnt(" #n ")" ::: "memory")
#define PG8_BAR __builtin_amdgcn_s_barrier()
#define PG8_SCHED __builtin_amdgcn_sched_barrier(0)
    Unit cur, nxt; int ui = 0;
    if (!S.next(0, cur)) return;
    f32x4 acc[2][2][4][2];
#pragma unroll
    for (int a = 0; a < 2; ++a)
#pragma unroll
        for (int b = 0; b < 2; ++b)
#pragma unroll
            for (int m = 0; m < 4; ++m)
#pragma unroll
                for (int n = 0; n < 2; ++n) acc[a][b][m][n] = (f32x4){0.f, 0.f, 0.f, 0.f};
    bf16x8 At[4][2], B0[2][2], B1[2][2];
    const char* cA = (const char*)g.A + (size_t)cur.pm * tstep; const char* cB = (const char*)g.Bt + (size_t)cur.pn * tstep;
    S.a_ready(cur);
    PG8_STAGE(PG8_SB(0, 0), cB, voffB); PG8_STAGE(PG8_SA(0, 0), cA, voffA); PG8_STAGE(PG8_SB(0, 1), cB + hstep, voffB); PG8_STAGE(PG8_SA(0, 1), cA + hstep, voffA);
    if (wr == 1) PG8_BAR;
    PG8_WAIT_V(4); PG8_BAR;
    PG8_STAGE(PG8_SB(1, 0), cB + kstep, voffB); PG8_STAGE(PG8_SA(1, 0), cA + kstep, voffA); PG8_STAGE(PG8_SB(1, 1), cB + hstep + kstep, voffB);
    PG8_WAIT_V(6); PG8_BAR;
    for (;;) {
        const bool has_next = S.next(ui + 1, nxt);
        const char* nA = has_next ? (const char*)g.A + (size_t)nxt.pm * tstep : cA; const char* nB = has_next ? (const char*)g.Bt + (size_t)nxt.pn * tstep : cB;
        for (int t = 0; t < nt; t += 2) {
            const bool last = (t == nt - 2);
            const char* a1 = cA + (size_t)(t + 1) * kstep;
            const char* a2 = last ? nA : cA + (size_t)(t + 2) * kstep; const char* b2 = last ? nB : cB + (size_t)(t + 2) * kstep;
            const char* a3 = a2 + kstep; const char* b3 = b2 + kstep;
            if (last && has_next) S.a_ready(nxt);
            PG8_LDB(B0, 0, 0); PG8_SCHED; PG8_LDA(At, 0, 0); PG8_STAGE(PG8_SA(1, 1), a1 + hstep, voffA);
            PG8_WAIT_L(8); PG8_BAR; PG8_WAIT_L(0); PG8_MMA(0, 0, At, B0); PG8_BAR; PG8_SCHED;
            PG8_LDB(B1, 0, 1); PG8_STAGE(PG8_SB(0, 0), b2, voffB);
            PG8_BAR; PG8_WAIT_L(0); PG8_MMA(0, 1, At, B1); PG8_BAR;
            PG8_LDA(At, 0, 1); PG8_STAGE(PG8_SA(0, 0), a2, voffA);
            PG8_BAR; PG8_WAIT_L(0); PG8_MMA(1, 0, At, B0); PG8_BAR; PG8_SCHED;
            PG8_STAGE(PG8_SB(0, 1), b2 + hstep, voffB);
            PG8_WAIT_V(6); PG8_BAR; PG8_MMA(1, 1, At, B1); PG8_BAR;
            PG8_LDB(B0, 1, 0); PG8_SCHED; PG8_LDA(At, 1, 0); PG8_STAGE(PG8_SA(0, 1), a2 + hstep, voffA);
            PG8_WAIT_L(8); PG8_BAR; PG8_WAIT_L(0); PG8_MMA(0, 0, At, B0); PG8_BAR; PG8_SCHED;
            PG8_LDB(B1, 1, 1); PG8_STAGE(PG8_SB(1, 0), b3, voffB);
            PG8_BAR; PG8_WAIT_L(0); PG8_MMA(0, 1, At, B1); PG8_BAR;
            PG8_LDA(At, 1, 1); PG8_STAGE(PG8_SA(1, 0), a3, voffA);
            PG8_BAR; PG8_WAIT_L(0); PG8_MMA(1, 0, At, B0); PG8_BAR; PG8_SCHED;
            PG8_STAGE(PG8_SB(1, 1), b3 + hstep, voffB);
            PG8_WAIT_V(6); PG8_BAR; PG8_MMA(1, 1, At, B1); PG8_BAR;
        }
        E(acc, cur, wr, wc, fr, fq); S.done(cur);
        if (!has_next) break;
#pragma unroll
        for (int a = 0; a < 2; ++a)
#pragma unroll
            for (int b = 0; b < 2; ++b)
#pragma unroll
                for (int m = 0; m < 4; ++m)
#pragma unroll
                    for (int n = 0; n < 2; ++n) acc[a][b][m][n] = (f32x4){0.f, 0.f, 0.f, 0.f};
        cur = nxt; cA = nA; cB = nB; ++ui;
    }
    PG8_WAIT_V(0);
    if (wr == 0) PG8_BAR;
    PG8_BAR;
#undef PG8_SA
#undef PG8_SB
#undef PG8_STAGE
#undef PG8_LDA
#undef PG8_LDB
#undef PG8_MMA
#undef PG8_WAIT_V
#undef PG8_WAIT_L
#undef PG8_BAR
#undef PG8_SCHED
}
}

struct EpiSwiGLU {
    static constexpr bool PERM = true;
    bf16_t* H;
    __device__ __forceinline__ void operator()(const f32x4 (&acc)[2][2][4][2], const pg8::Unit& u, int wr, int wc, int fr, int fq) const {
        const int row0 = u.pm * 256 + wr * 64 + fr, col0 = u.pn * 128 + wc * 32 + 8 * fq;
#pragma unroll
        for (int ai = 0; ai < 2; ++ai)
#pragma unroll
            for (int m = 0; m < 4; ++m) {
                bf16_t* rowp = H + (size_t)(row0 + ai * 128 + m * 16) * DFF + col0;
                float h[8];
#pragma unroll
                for (int n = 0; n < 2; ++n)
#pragma unroll
                    for (int j = 0; j < 4; ++j) { const float gt = acc[ai][0][m][n][j], up = acc[ai][1][m][n][j]; h[n * 4 + j] = siluf_(gt) * up; }
                u32x4 w; w.x = cvt_pk_bf16(h[0], h[1]); w.y = cvt_pk_bf16(h[2], h[3]); w.z = cvt_pk_bf16(h[4], h[5]); w.w = cvt_pk_bf16(h[6], h[7]);
                *(u32x4*)rowp = w;
            }
    }
};
struct EpiBf16 {
    static constexpr bool PERM = true;
    bf16_t* O; int ldl; bf16_t* OC; int ldc;
    __device__ __forceinline__ void operator()(const f32x4 (&acc)[2][2][4][2], const pg8::Unit& u, int wr, int wc, int fr, int fq) const {
        const bool isc = u.pm >= 128;
        bf16_t* base = isc ? OC : O; const int ld = isc ? ldc : ldl;
        const int row0 = (isc ? (u.pm - 128) : u.pm) * 256 + wr * 64 + fr, col0 = u.pn * 256 + wc * 32 + 8 * fq;
#pragma unroll
        for (int ai = 0; ai < 2; ++ai)
#pragma unroll
            for (int m = 0; m < 4; ++m) {
                bf16_t* rowp = base + (size_t)(row0 + ai * 128 + m * 16) * ld + col0;
#pragma unroll
                for (int bj = 0; bj < 2; ++bj) {
                    const f32x4 v0 = acc[ai][bj][m][0], v1 = acc[ai][bj][m][1];
                    u32x4 w; w.x = cvt_pk_bf16(v0[0], v0[1]); w.y = cvt_pk_bf16(v0[2], v0[3]); w.z = cvt_pk_bf16(v1[0], v1[1]); w.w = cvt_pk_bf16(v1[2], v1[3]);
                    *(u32x4*)(rowp + bj * 128) = w;
                }
            }
    }
};
struct EpiRes {
    static constexpr bool PERM = false;
    const float* srcL; float* dstL; const float* srcC; float* dstC; const float* gate; float coef; int frow = -1;
    __device__ __forceinline__ void operator()(const f32x4 (&acc)[2][2][4][2], const pg8::Unit& u, int wr, int wc, int fr, int fq) const {
        const bool isc = u.pm >= 128;
        const float* src = isc ? srcC : srcL; float* dst = isc ? dstC : dstL;
        const int modrow = (frow >= 0) ? frow : (isc ? 8 : (u.pm >> 4));
        const int row0 = (isc ? (u.pm - 128) : u.pm) * 256 + wr * 64 + fr, col0 = u.pn * 256 + wc * 32 + 4 * fq;
        const float* gp = gate + (size_t)modrow * MODC + col0;
        f32x4 gv[2][2];
#pragma unroll
        for (int bj = 0; bj < 2; ++bj)
#pragma unroll
            for (int n = 0; n < 2; ++n) gv[bj][n] = *(const f32x4*)(gp + bj * 128 + n * 16) * coef;
#pragma unroll
        for (int ai = 0; ai < 2; ++ai) {
            f32x4 sv[4][2][2];
#pragma unroll
            for (int m = 0; m < 4; ++m) {
                const size_t ro = (size_t)(row0 + ai * 128 + m * 16) * DM + col0;
#pragma unroll
                for (int bj = 0; bj < 2; ++bj)
#pragma unroll
                    for (int n = 0; n < 2; ++n) sv[m][bj][n] = *(const f32x4*)(src + ro + bj * 128 + n * 16);
            }
            asm volatile("" ::: "memory");
#pragma unroll
            for (int m = 0; m < 4; ++m) {
                const size_t ro = (size_t)(row0 + ai * 128 + m * 16) * DM + col0;
#pragma unroll
                for (int bj = 0; bj < 2; ++bj)
#pragma unroll
                    for (int n = 0; n < 2; ++n) *(f32x4*)(dst + ro + bj * 128 + n * 16) = sv[m][bj][n] + gv[bj][n] * acc[ai][bj][m][n];
            }
            asm volatile("" ::: "memory");
        }
    }
};


template <class Epi, class Sched>
__device__ __forceinline__ void gemm_simple(const pg8::Gemm g, const Sched& S, const Epi& E) {
    const int tid = tid_opaque(), wid = tid >> 6, lane = tid & 63, wr = wid >> 2, wc = wid & 3, fr = lane & 15, fq = lane >> 4;
    const int K = g.K;
    pg8::Unit u;
    for (int i = 0; S.next(i, u); ++i) {
        f32x4 acc[2][2][4][2];
#pragma unroll
        for (int a = 0; a < 2; ++a)
#pragma unroll
            for (int b = 0; b < 2; ++b)
#pragma unroll
                for (int m = 0; m < 4; ++m)
#pragma unroll
                    for (int n = 0; n < 2; ++n) acc[a][b][m][n] = (f32x4){0.f, 0.f, 0.f, 0.f};
        const bf16_t* Ab = g.A + (size_t)(u.pm * 256 + wr * 64 + fr) * K + fq * 8;
        const bf16_t* Bb0 = g.Bt + (size_t)(u.pn * 256 + wc * 32 + (Epi::PERM ? pg8::perm32(fr) : fr)) * K + fq * 8;
        const bf16_t* Bb1 = g.Bt + (size_t)(u.pn * 256 + wc * 32 + (Epi::PERM ? pg8::perm32(16 + fr) : 16 + fr)) * K + fq * 8;
#pragma unroll 1
        for (int k0 = 0; k0 < K; k0 += 32) {
            bf16x8 a[2][4], b[2][2];
#pragma unroll
            for (int ai = 0; ai < 2; ++ai)
#pragma unroll
                for (int m = 0; m < 4; ++m) a[ai][m] = *(const bf16x8*)(Ab + (size_t)(ai * 128 + m * 16) * K + k0);
#pragma unroll
            for (int bj = 0; bj < 2; ++bj) { b[bj][0] = *(const bf16x8*)(Bb0 + (size_t)(bj * 128) * K + k0); b[bj][1] = *(const bf16x8*)(Bb1 + (size_t)(bj * 128) * K + k0); }
#pragma unroll
            for (int ai = 0; ai < 2; ++ai)
#pragma unroll
                for (int bj = 0; bj < 2; ++bj)
#pragma unroll
                    for (int m = 0; m < 4; ++m)
#pragma unroll
                        for (int n = 0; n < 2; ++n) acc[ai][bj][m][n] = __builtin_amdgcn_mfma_f32_16x16x32_bf16(b[bj][n], a[ai][m], acc[ai][bj][m][n], 0, 0, 0);
        }
        E(acc, u, wr, wc, fr, fq);
    }
}
#define GEMM_RUN(phn, g, S, E) do { if (SIMPLE_GEMM & (1 << (phn))) gemm_simple(g, S, E); else pg8::gemm_phase(lds, g, S, E); } while (0)

__device__ __forceinline__ void tr_tile(const float* __restrict__ src, int N, bf16_t* __restrict__ dst, int K, int k0, int n0, int rs, int off, float* tile) {
    const int tid = tid_opaque();
    const int c4 = (tid & 15) * 4;
#pragma unroll
    for (int pss = 0; pss < 2; ++pss) {
        const int r = (tid >> 4) + 32 * pss;
        const float4 x = *(const float4*)(src + (size_t)(k0 + r) * N + n0 + c4);
        float* t = tile + r * 65 + c4; t[0] = x.x; t[1] = x.y; t[2] = x.z; t[3] = x.w;
    }
    __syncthreads();
    const int n = tid >> 3, kq = tid & 7;
    float e[8];
#pragma unroll
    for (int j = 0; j < 8; ++j) e[j] = tile[(kq * 8 + j) * 65 + n];
    const int nn = n0 + n, row = (nn >> 7) * rs + off + (nn & 127);
    u32x4 w; w.x = cvt_pk_bf16(e[0], e[1]); w.y = cvt_pk_bf16(e[2], e[3]); w.z = cvt_pk_bf16(e[4], e[5]); w.w = cvt_pk_bf16(e[6], e[7]);
    *(u32x4*)(dst + (size_t)row * K + k0 + kq * 8) = w;
    __syncthreads();
}

__device__ __forceinline__ void prep_tiles(const Params& p, unsigned char* shm, int t_begin, int t_end, int start, int stride) {
    float* tile = (float*)shm;
    for (int t = t_begin + start; t < t_end; t += stride) {
        int job, lt = t;
        if (lt < 2816) job = 0; else if ((lt -= 2816) < 2816) job = 1; else if ((lt -= 2816) < 2816) job = 2; else if ((lt -= 2816) < 4096) job = 3;
        else if ((lt -= 4096) < 1024) job = 4; else if ((lt -= 1024) < 2816) job = 5; else if ((lt -= 2816) < 2816) job = 6; else { lt -= 2816; job = 7; }
        const float* src; bf16_t* dst; int K, N, rs = 128, off = 0;
        switch (job) {
            case 0: src = p.in[I_F1W1]; dst = (bf16_t*)(p.ws + WS_W13A); K = DM; N = DFF; rs = 256; break;
            case 1: src = p.in[I_F1W3]; dst = (bf16_t*)(p.ws + WS_W13A); K = DM; N = DFF; rs = 256; off = 128; break;
            case 2: src = p.in[I_F1W2]; dst = (bf16_t*)(p.ws + WS_W2A); K = DFF; N = DM; break;
            case 3: src = p.in[I_WIN]; dst = (bf16_t*)(p.ws + WS_WIN); K = DM; N = INC; break;
            case 4: src = p.in[I_WOUT]; dst = (bf16_t*)(p.ws + WS_WOUT); K = DM; N = DM; break;
            case 5: src = p.in[I_F2W1]; dst = (bf16_t*)(p.ws + WS_W13B); K = DM; N = DFF; rs = 256; break;
            case 6: src = p.in[I_F2W3]; dst = (bf16_t*)(p.ws + WS_W13B); K = DM; N = DFF; rs = 256; off = 128; break;
            default: src = p.in[I_F2W2]; dst = (bf16_t*)(p.ws + WS_W2B); K = DFF; N = DM; break;
        }
        const int nkt = K >> 6;
        const int kt = lt % nkt, ntl = lt / nkt;
        tr_tile(src, N, dst, K, kt * 64, ntl * 64, rs, off, tile);
    }
}

__device__ __forceinline__ void phase_prep(const Params& p, unsigned char* shm, bool defer_ffn2) {
    const int tid = tid_opaque(), G = gridDim.x, bid = blockIdx.x;
    if (defer_ffn2) { prep_tiles(p, shm, 0, 8448, bid, G); prep_tiles(p, shm, 10496, 12544, bid, G); }
    else prep_tiles(p, shm, 0, 22016, bid, G);
    {
        float* s = (float*)shm;
        float* modp = (float*)(p.ws + WS_MODP);
        for (int it = bid; it < 288; it += G) {
            const int cgp = it % 36, ks = it / 36;
            __syncthreads();
            if (tid < 256) {
#pragma unroll
                for (int j = 0; j < 9; ++j) { const float cv = (j < 8) ? p.in[I_C][j * DM + ks * 256 + tid] : p.in[I_CCTX][ks * 256 + tid]; s[j * 256 + tid] = siluf_(cv); }
            }
            __syncthreads();
            const int col = cgp * 512 + tid;
            const float* wp = p.in[I_ADAW] + (size_t)(ks * 256) * MODC + col;
            float acc[9];
#pragma unroll
            for (int j = 0; j < 9; ++j) acc[j] = 0.f;
#pragma unroll 2
            for (int k = 0; k < 256; k += 4) {
                const float w0 = wp[(size_t)(k + 0) * MODC], w1 = wp[(size_t)(k + 1) * MODC], w2 = wp[(size_t)(k + 2) * MODC], w3 = wp[(size_t)(k + 3) * MODC];
#pragma unroll
                for (int j = 0; j < 9; ++j) { const float4 sv = *(const float4*)&s[j * 256 + k]; acc[j] += sv.x * w0 + sv.y * w1 + sv.z * w2 + sv.w * w3; }
            }
#pragma unroll
            for (int j = 0; j < 9; ++j) modp[((size_t)ks * 9 + j) * MODC + col] = acc[j];
        }
        __syncthreads();
    }
    {
        float* z = (float*)shm;
        float* h1 = z + 8 * 36;
        float* h2 = h1 + 8 * 64;
        float* hid3T = (float*)(p.ws + WS_HID3);
        const int lg = tid >> 6, unit = tid & 63;
        const float fr = p.in[I_FFREQ][unit];
        for (int it = bid; it < 512; it += G) {
            const int lag = it * 8 + lg;
            __syncthreads();
            if (unit < 33) {
                float val;
                if (unit == 0) val = (float)lag / 4095.0f;
                else {
                    const int i = (unit - 1) & 15;
                    const float fb = 1e-4f + (float)i * ((15.0f - 1e-4f) / 15.0f);
                    const float ang = (0.0015339807878856412f * (float)lag) * fb;
                    val = (unit <= 16) ? cos_rad(ang) : -sin_rad(ang);
                }
                z[lg * 36 + unit] = val;
            }
            __syncthreads();
            float a = p.in[I_FB1][unit];
#pragma unroll 3
            for (int i = 0; i < 33; ++i) a += z[lg * 36 + i] * p.in[I_FW1][i * 64 + unit];
            h1[lg * 64 + unit] = sin_rad(fr * a);
            __syncthreads();
            a = p.in[I_FB2][unit];
#pragma unroll 8
            for (int i = 0; i < 64; ++i) a += h1[lg * 64 + i] * p.in[I_FW2][i * 64 + unit];
            h2[lg * 64 + unit] = sin_rad(fr * a);
            __syncthreads();
            a = p.in[I_FB3][unit];
#pragma unroll 8
            for (int i = 0; i < 64; ++i) a += h2[lg * 64 + i] * p.in[I_FW3][i * 64 + unit];
            hid3T[unit * 4096 + lag] = sin_rad(fr * a);
        }
        __syncthreads();
    }
}

__device__ __forceinline__ void phase_modreduce(const Params& p) {
    const float* modp = (const float*)(p.ws + WS_MODP);
    float* mod = (float*)(p.ws + WS_MOD);
    for (int i = blockIdx.x * 512 + tid_opaque(); i < 9 * MODC; i += gridDim.x * 512) {
        const int col = i % MODC;
        float a = p.in[I_ADAB][col];
#pragma unroll
        for (int ks = 0; ks < 8; ++ks) a += modp[(size_t)ks * 9 * MODC + i];
        mod[i] = a;
    }
}

__device__ __forceinline__ void phase_norm(const Params& p, const float* srcL, const float* srcC, int r_begin, int r_end, const float* gw, int sidx, int blk, int nblk) {
    const int tid = tid_opaque(); const int lane = tid & 63, gwv = blk * 8 + (tid >> 6), nw = nblk * 8; const int nrows = r_end - r_begin;
    const float* mod = (const float*)(p.ws + WS_MOD);
    bf16_t* A = (bf16_t*)(p.ws + WS_ABUF);
    const int per = (nrows + nw - 1) / nw, r_lo = r_begin + gwv * per, r_hi = (r_lo + per < r_end) ? (r_lo + per) : r_end;
    float4 g[8], s0[8], s1[8];
#pragma unroll
    for (int i = 0; i < 8; ++i) g[i] = *(const float4*)(gw + (i * 64 + lane) * 4);
    int cur = -1;
    for (int r = r_lo; r < r_hi; ++r) {
        const float* src = (r < ML) ? srcL + (size_t)r * DM : srcC + (size_t)(r - ML) * DM;
        const int mrow = (r < ML) ? (r >> 12) : 8;
        float4 xv[8]; float ss = 0.f;
#pragma unroll
        for (int i = 0; i < 8; ++i) xv[i] = *(const float4*)(src + (i * 64 + lane) * 4);
        if (mrow != cur) {
            cur = mrow;
            const float* sh = mod + (size_t)mrow * MODC + sidx * DM; const float* sc = sh + DM;
#pragma unroll
            for (int i = 0; i < 8; ++i) { s0[i] = *(const float4*)(sh + (i * 64 + lane) * 4); s1[i] = *(const float4*)(sc + (i * 64 + lane) * 4); }
        }
#pragma unroll
        for (int i = 0; i < 8; ++i) ss += xv[i].x * xv[i].x + xv[i].y * xv[i].y + xv[i].z * xv[i].z + xv[i].w * xv[i].w;
        ss = wave_sum(ss);
        const float inv = rsqrtf(ss * (1.0f / DM) + 1e-6f);
        u32x2 wv[8];
#pragma unroll
        for (int i = 0; i < 8; ++i) {
            const float o0 = xv[i].x * inv * g[i].x * (1.f + s1[i].x) + s0[i].x, o1 = xv[i].y * inv * g[i].y * (1.f + s1[i].y) + s0[i].y;
            const float o2 = xv[i].z * inv * g[i].z * (1.f + s1[i].z) + s0[i].z, o3 = xv[i].w * inv * g[i].w * (1.f + s1[i].w) + s0[i].w;
            wv[i].x = cvt_pk_bf16(o0, o1); wv[i].y = cvt_pk_bf16(o2, o3);
        }
#pragma unroll
        for (int i = 0; i < 8; ++i) *(u32x2*)(A + (size_t)r * DM + (i * 64 + lane) * 4) = wv[i];
    }
}

__device__ __forceinline__ void phase_final_norm(const Params& p) {
    const int tid = tid_opaque(); const int lane = tid & 63, gwv = blockIdx.x * 8 + (tid >> 6), nw = gridDim.x * 8;
    const float* gw = p.in[I_FNORM];
    const int per = (ML + nw - 1) / nw, r_lo = gwv * per, r_hi = (r_lo + per < ML) ? (r_lo + per) : ML;
    float4 g[8];
#pragma unroll
    for (int i = 0; i < 8; ++i) g[i] = *(const float4*)(gw + (i * 64 + lane) * 4);
    for (int r = r_lo; r < r_hi; ++r) {
        float* row = p.out + (size_t)r * DM;
        float4 xv[8]; float ss = 0.f;
#pragma unroll
        for (int i = 0; i < 8; ++i) xv[i] = *(const float4*)(row + (i * 64 + lane) * 4);
#pragma unroll
        for (int i = 0; i < 8; ++i) ss += xv[i].x * xv[i].x + xv[i].y * xv[i].y + xv[i].z * xv[i].z + xv[i].w * xv[i].w;
        ss = wave_sum(ss);
        const float inv = rsqrtf(ss * (1.0f / DM) + 1e-6f);
#pragma unroll
        for (int i = 0; i < 8; ++i)
            *(float4*)(row + (i * 64 + lane) * 4) = make_float4(xv[i].x * inv * g[i].x, xv[i].y * inv * g[i].y, xv[i].z * inv * g[i].z, xv[i].w * inv * g[i].w);
    }
}

__device__ __forceinline__ void phase_shortconv(const Params& p, unsigned char* shm, int t_start, int t_stride) {
    const int tid = tid_opaque();
    float* tile = (float*)shm;
    const bf16_t* PX = (const bf16_t*)(p.ws + WS_C);
    bf16_t* UT = (bf16_t*)(p.ws + WS_F);
    for (int t = t_start; t < NB * 64 * 12; t += t_stride) {
        const int cg4 = t % 12, gr = (t / 12) & 63, b = t / (12 * 64);
        {
            const int tt = tid >> 3, c8 = (tid & 7) * 8;
            u32x4 w[4];
#pragma unroll
            for (int q = 0; q < 4; ++q) w[q] = *(const u32x4*)(PX + (size_t)(b * SEQ + gr * 64 + tt) * INC + 5120 + (cg4 * 4 + q) * 64 + c8);
#pragma unroll
            for (int q = 0; q < 4; ++q) {
                float* tp = tile + q * (64 * 65) + tt * 65 + c8;
                tp[0] = bf_lo(w[q].x); tp[1] = bf_hi(w[q].x); tp[2] = bf_lo(w[q].y); tp[3] = bf_hi(w[q].y); tp[4] = bf_lo(w[q].z); tp[5] = bf_hi(w[q].z); tp[6] = bf_lo(w[q].w); tp[7] = bf_hi(w[q].w);
            }
        }
        __syncthreads();
#pragma unroll
        for (int q = 0; q < 4; ++q) {
            const int cc = tid >> 3, t8 = (tid & 7) * 8, ch = (cg4 * 4 + q) * 64 + cc;
            const float* tq = tile + q * (64 * 65);
            const float w0 = p.in[I_HCW][ch], w1 = p.in[I_HCW][3072 + ch], w2 = p.in[I_HCW][6144 + ch], bb = p.in[I_HCB][ch];
            float u[10];
#pragma unroll
            for (int j = 0; j < 10; ++j) { const int tt = t8 - 1 + j; u[j] = (tt >= 0 && tt < 64) ? tq[tt * 65 + cc] : 0.f; }
            float o[8];
#pragma unroll
            for (int j = 0; j < 8; ++j) o[j] = u[j] * w0 + u[j + 1] * w1 + u[j + 2] * w2 + bb;
            u32x4 w; w.x = cvt_pk_bf16(o[0], o[1]); w.y = cvt_pk_bf16(o[2], o[3]); w.z = cvt_pk_bf16(o[4], o[5]); w.w = cvt_pk_bf16(o[6], o[7]);
            *(u32x4*)(UT + ((size_t)(b * 3072 + ch)) * SEQ + gr * 64 + t8) = w;
        }
        __syncthreads();
    }
}

__device__ __forceinline__ int hg_row(int c, int s, int dir, int b) {
    if (c < 8) { const int q = c * 32 + s; return b * CTXL + (dir ? (CTXL - 1 - q) : q); }
    const int q = (c - 8) * 32 + s; return b * SEQ + (dir ? (SEQ - 1 - q) : q);
}
__device__ __forceinline__ void hgrn_item(const Params& p, int item, unsigned char* shm) {
    const int tid = tid_opaque(), w = tid >> 6, lane = tid & 63;
    const int dir = item & 1, vh = (item >> 1) & 1, h = (item >> 2) & 7, b = item >> 5;
    float* F = (float*)shm;
    float* Q = F + 32 * 128;
    float* V = Q + 32 * 128;
    float* OP = V + 32 * 64;
    const bf16_t* PX = (const bf16_t*)(p.ws + WS_C);
    const bf16_t* PXC = (const bf16_t*)(p.ws + WS_PXC);
    bf16_t* MIX = (bf16_t*)(p.ws + WS_ABUF);
    const int ls = tid >> 4, lk = (tid & 15) * 8;
    const int vs = (tid >> 3) & 31, v8 = (tid & 7) * 8;
    float lbv[8];
#pragma unroll
    for (int i = 0; i < 8; ++i) { const int j = h * 128 + lk + i; lbv[i] = sigmoidf_(p.in[I_LB][dir * 2048 + j] - p.in[I_LB][dir * 2048 + 1024 + j]); }
    f32x4 S4[4];
#pragma unroll
    for (int i = 0; i < 4; ++i) S4[i] = (f32x4){0.f, 0.f, 0.f, 0.f};
    const int vg4 = (lane >> 2) * 4, kq4 = (lane & 3) * 4;
    u32x4 rf, rq, rv;
    rq = (u32x4){0u, 0u, 0u, 0u}; rv = rq;
#if SKIP_CTX
    {
        const size_t ro = (size_t)hg_row(8, ls, dir, b) * INC;
        rf = *(const u32x4*)(PX + ro + dir * 1024 + h * 128 + lk);
        rq = *(const u32x4*)(PX + ro + 3072 + h * 128 + lk);
        if (tid < 256) rv = *(const u32x4*)(PX + (size_t)hg_row(8, vs, dir, b) * INC + 2048 + h * 128 + vh * 64 + v8);
    }
    for (int c = 8; c < 136; ++c) {
#else
    {
        const size_t ro = (size_t)hg_row(0, ls, dir, b) * 3072;
        rf = *(const u32x4*)(PXC + ro + dir * 1024 + h * 128 + lk);
        if (tid < 256) rv = *(const u32x4*)(PXC + (size_t)hg_row(0, vs, dir, b) * 3072 + 2048 + h * 128 + vh * 64 + v8);
    }
    for (int c = 0; c < 136; ++c) {
#endif
        const bool lat = c >= 8;
        __syncthreads();
        {
            float* fp = F + ls * 128 + lk;
            const float a0 = bf_lo(rf.x), a1 = bf_hi(rf.x), a2 = bf_lo(rf.y), a3 = bf_hi(rf.y), a4 = bf_lo(rf.z), a5 = bf_hi(rf.z), a6 = bf_lo(rf.w), a7 = bf_hi(rf.w);
            *(float4*)fp = make_float4(lbv[0] + (1.f - lbv[0]) * sigmoidf_(a0), lbv[1] + (1.f - lbv[1]) * sigmoidf_(a1), lbv[2] + (1.f - lbv[2]) * sigmoidf_(a2), lbv[3] + (1.f - lbv[3]) * sigmoidf_(a3));
            *(float4*)(fp + 4) = make_float4(lbv[4] + (1.f - lbv[4]) * sigmoidf_(a4), lbv[5] + (1.f - lbv[5]) * sigmoidf_(a5), lbv[6] + (1.f - lbv[6]) * sigmoidf_(a6), lbv[7] + (1.f - lbv[7]) * sigmoidf_(a7));
            if (lat) {
                const float qs = 0.08838834764831845f;
                float* qp = Q + ls * 128 + lk;
                *(float4*)qp = make_float4(bf_lo(rq.x) * qs, bf_hi(rq.x) * qs, bf_lo(rq.y) * qs, bf_hi(rq.y) * qs);
                *(float4*)(qp + 4) = make_float4(bf_lo(rq.z) * qs, bf_hi(rq.z) * qs, bf_lo(rq.w) * qs, bf_hi(rq.w) * qs);
            }
            if (tid < 256) {
                float* vp = V + vs * 64 + v8;
                *(float4*)vp = make_float4(bf_lo(rv.x), bf_hi(rv.x), bf_lo(rv.y), bf_hi(rv.y));
                *(float4*)(vp + 4) = make_float4(bf_lo(rv.z), bf_hi(rv.z), bf_lo(rv.w), bf_hi(rv.w));
            }
        }
        __syncthreads();
        if (c + 1 < 136) {
            const int cn = c + 1;
            if (cn < 8) {
                rf = *(const u32x4*)(PXC + (size_t)hg_row(cn, ls, dir, b) * 3072 + dir * 1024 + h * 128 + lk);
                if (tid < 256) rv = *(const u32x4*)(PXC + (size_t)hg_row(cn, vs, dir, b) * 3072 + 2048 + h * 128 + vh * 64 + v8);
            } else {
                const size_t ro = (size_t)hg_row(cn, ls, dir, b) * INC;
                rf = *(const u32x4*)(PX + ro + dir * 1024 + h * 128 + lk);
                rq = *(const u32x4*)(PX + ro + 3072 + h * 128 + lk);
                if (tid < 256) rv = *(const u32x4*)(PX + (size_t)hg_row(cn, vs, dir, b) * INC + 2048 + h * 128 + vh * 64 + v8);
            }
        }
        if (!lat) {
#pragma unroll 4
            for (int s = 0; s < 32; ++s) {
                const f32x4 v4 = *(const f32x4*)&V[s * 64 + vg4];
                const f32x4 f4 = *(const f32x4*)&F[s * 128 + w * 16 + kq4];
#pragma unroll
                for (int kk = 0; kk < 4; ++kk) {
                    const float fk = f4[kk];
                    const f32x4 t = v4 - fk * v4;
                    S4[kk] = fk * S4[kk] + t;
                }
            }
        } else {
#pragma unroll 4
            for (int s = 0; s < 32; ++s) {
                const f32x4 v4 = *(const f32x4*)&V[s * 64 + vg4];
                const f32x4 f4 = *(const f32x4*)&F[s * 128 + w * 16 + kq4];
                const f32x4 q4 = *(const f32x4*)&Q[s * 128 + w * 16 + kq4];
                f32x4 o = (f32x4){0.f, 0.f, 0.f, 0.f};
#pragma unroll
                for (int kk = 0; kk < 4; ++kk) {
                    const float fk = f4[kk];
                    const f32x4 t = v4 - fk * v4;
                    S4[kk] = fk * S4[kk] + t;
                    o += S4[kk] * q4[kk];
                }
#pragma unroll
                for (int j = 0; j < 4; ++j) {
                    float x = o[j];
                    x += __int_as_float(__builtin_amdgcn_update_dpp(0, __float_as_int(x), 0xB1, 0xf, 0xf, true));
                    x += __int_as_float(__builtin_amdgcn_update_dpp(0, __float_as_int(x), 0x4E, 0xf, 0xf, true));
                    o[j] = x;
                }
                if ((lane & 3) == 0) *(f32x4*)&OP[(w * 32 + s) * 64 + vg4] = o;
            }
            __syncthreads();
            {
                const int s = tid >> 4, v4 = (tid & 15) * 4;
                float4 a = *(const float4*)&OP[s * 64 + v4];
#pragma unroll
                for (int ww = 1; ww < 8; ++ww) { const float4 t = *(const float4*)&OP[(ww * 32 + s) * 64 + v4]; a.x += t.x; a.y += t.y; a.z += t.z; a.w += t.w; }
                u32x2 pk; pk.x = cvt_pk_bf16(a.x, a.y); pk.y = cvt_pk_bf16(a.z, a.w);
                *(u32x2*)(MIX + (size_t)hg_row(c, s, dir, b) * DM + dir * 1024 + h * 128 + vh * 64 + v4) = pk;
            }
        }
    }
    __syncthreads();
}


__device__ __forceinline__ int hg_row16(int c, int t, int dir, int b) {
    if (c < 16) { const int q = c * 16 + t; return b * CTXL + (dir ? (CTXL - 1 - q) : q); }
    const int q = (c - 16) * 16 + t; return b * SEQ + (dir ? (SEQ - 1 - q) : q);
}
__device__ __forceinline__ void hgrn_mfma_item(const Params& p, int item, unsigned char* shm) {
    const int tid = tid_opaque(), w = tid >> 6, lane = tid & 63, fr = lane & 15, fq = lane >> 4;
    const int dir = item & 1, h = (item >> 1) & 7, b = item >> 4;
    const bf16_t* PX = (const bf16_t*)(p.ws + WS_C);
    const bf16_t* PXC = (const bf16_t*)(p.ws + WS_PXC);
    bf16_t* MIX = (bf16_t*)(p.ws + WS_ABUF);
    const int kl = lane & 15, sq = lane >> 4, kcol = 16 * w + kl;
    const float lb = sigmoidf_(p.in[I_LB][dir * 2048 + h * 128 + kcol] - p.in[I_LB][dir * 2048 + 1024 + h * 128 + kcol]);
    f32x4 Sacc[8];
#pragma unroll
    for (int i = 0; i < 8; ++i) Sacc[i] = (f32x4){0.f, 0.f, 0.f, 0.f};
    bf16_t ra[4], rq[4], rv[4];
    const long sgn = dir ? -1 : 1;
    const bf16_t* pa[4]; const bf16_t* pv[4]; bf16_t* po[4];
#pragma unroll
    for (int j = 0; j < 4; ++j) {
        const long r0 = (long)b * CTXL + (dir ? CTXL - 1 : 0) + sgn * (4 * sq + j);
        pa[j] = PXC + r0 * 3072 + dir * 1024 + h * 128 + kcol; pv[j] = PXC + r0 * 3072 + 2048 + h * 128 + kcol;
        ra[j] = pa[j][0]; rv[j] = pv[j][0]; rq[j] = 0;
        po[j] = MIX + ((long)b * SEQ + (dir ? SEQ - 1 : 0) + sgn * (4 * fq + j)) * DM + dir * 1024 + h * 128 + 16 * w + fr;
    }
    for (int c = 0; c < 272; ++c) {
        const bool lat = c >= 16;
        unsigned char* sb = shm + (c & 1) * 36864;
        bf16_t* QT = (bf16_t*)(sb);
        bf16_t* KH = (bf16_t*)(sb + 4352);
        bf16_t* KTp = (bf16_t*)(sb + 8704);
        bf16_t* Vp = (bf16_t*)(sb + 13824);
        float* DEC = (float*)(sb + 18944);
        float kk[4], bt[4], qq[4], vv[4];
        {
            float run = 0.f;
#pragma unroll
            for (int j = 0; j < 4; ++j) {
                const float fj = lb + (1.f - lb) * sigmoidf_(bf2f(ra[j]));
                kk[j] = 1.f - fj; run += __logf(fj); bt[j] = run;
                qq[j] = bf2f(rq[j]) * 0.08838834764831845f; vv[j] = bf2f(rv[j]);
            }
            float x = run;
            const float y = __shfl_up(x, 16); if (sq >= 1) x += y;
            const float z = __shfl_up(x, 32); if (sq >= 2) x += z;
            const float excl = x - run;
            const float bend = __shfl(x, 48 + kl);
#pragma unroll
            for (int j = 0; j < 4; ++j) bt[j] += excl;
            if (c + 1 < 272) {
                const int cn = c + 1;
                if (cn == 16) {
#pragma unroll
                    for (int j = 0; j < 4; ++j) { const long r0 = (long)b * SEQ + (dir ? SEQ - 1 : 0) + sgn * (4 * sq + j);
                        pa[j] = PX + r0 * INC + dir * 1024 + h * 128 + kcol; pv[j] = PX + r0 * INC + 2048 + h * 128 + kcol; }
                } else {
                    const long st = sgn * 16 * (cn < 16 ? 3072 : INC);
#pragma unroll
                    for (int j = 0; j < 4; ++j) { pa[j] += st; pv[j] += st; }
                }
#pragma unroll
                for (int j = 0; j < 4; ++j) { ra[j] = pa[j][0]; rv[j] = pv[j][0]; if (cn >= 16) rq[j] = pv[j][1024]; }
            }
#pragma unroll
            for (int j = 0; j < 4; ++j) {
                const int st = 4 * sq + j;
                QT[st * 136 + kcol] = (bf16_t)(cvt_pk_safe(qq[j] * __expf(bt[j]), 0.f) & 0xffffu);
                KH[st * 136 + kcol] = (bf16_t)(cvt_pk_safe(kk[j] * __expf(-bt[j]), 0.f) & 0xffffu);
            }
            {
                u32x2 wk, wv;
                wk.x = cvt_pk_safe(kk[0] * __expf(bend - bt[0]), kk[1] * __expf(bend - bt[1])); wk.y = cvt_pk_safe(kk[2] * __expf(bend - bt[2]), kk[3] * __expf(bend - bt[3]));
                wv.x = cvt_pk_safe(vv[0], vv[1]); wv.y = cvt_pk_safe(vv[2], vv[3]);
                *(u32x2*)(KTp + kcol * 20 + 4 * sq) = wk;
                *(u32x2*)(Vp + kcol * 20 + 4 * sq) = wv;
            }
            if (sq == 3) DEC[kcol] = __expf(bend);
        }
        __syncthreads();
        u32x4 vbu; { const u32x2 t2 = *(const u32x2*)(Vp + (16 * w + fr) * 20 + 4 * fq); vbu.x = t2.x; vbu.y = t2.y; vbu.z = 0u; vbu.w = 0u; }
        const bf16x8 vb = __builtin_bit_cast(bf16x8, vbu);
        if (lat) {
            f32x4 at = (f32x4){0.f, 0.f, 0.f, 0.f};
#pragma unroll
            for (int ks = 0; ks < 4; ++ks) {
                const bf16x8 a = *(const bf16x8*)(KH + fr * 136 + ks * 32 + fq * 8);
                const bf16x8 bq = *(const bf16x8*)(QT + fr * 136 + ks * 32 + fq * 8);
                at = __builtin_amdgcn_mfma_f32_16x16x32_bf16(a, bq, at, 0, 0, 0);
            }
            asm volatile("s_nop 7\n\ts_nop 7" ::: "memory");
            u32x4 pau;
            {
                const float m0 = (4 * fq + 0 <= fr) ? at[0] : 0.f, m1 = (4 * fq + 1 <= fr) ? at[1] : 0.f, m2 = (4 * fq + 2 <= fr) ? at[2] : 0.f, m3 = (4 * fq + 3 <= fr) ? at[3] : 0.f;
                pau.x = cvt_pk_safe(m0, m1); pau.y = cvt_pk_safe(m2, m3); pau.z = 0u; pau.w = 0u;
            }
            f32x4 o = (f32x4){0.f, 0.f, 0.f, 0.f};
#pragma unroll
            for (int ks = 0; ks < 4; ++ks) {
                const u32x2 q0 = *(const u32x2*)(QT + fr * 136 + ks * 32 + 4 * fq), q1 = *(const u32x2*)(QT + fr * 136 + ks * 32 + 16 + 4 * fq);
                u32x4 au; au.x = q0.x; au.y = q0.y; au.z = q1.x; au.w = q1.y;
                u32x4 bu; bu.x = cvt_pk_safe(Sacc[2 * ks][0], Sacc[2 * ks][1]); bu.y = cvt_pk_safe(Sacc[2 * ks][2], Sacc[2 * ks][3]);
                bu.z = cvt_pk_safe(Sacc[2 * ks + 1][0], Sacc[2 * ks + 1][1]); bu.w = cvt_pk_safe(Sacc[2 * ks + 1][2], Sacc[2 * ks + 1][3]);
                o = __builtin_amdgcn_mfma_f32_16x16x32_bf16(__builtin_bit_cast(bf16x8, au), __builtin_bit_cast(bf16x8, bu), o, 0, 0, 0);
            }
            o = __builtin_amdgcn_mfma_f32_16x16x32_bf16(__builtin_bit_cast(bf16x8, pau), vb, o, 0, 0, 0);
#pragma unroll
            for (int r = 0; r < 4; ++r)
                { unsigned ub = __float_as_uint(o[r]); ub += 0x7fffu + ((ub >> 16) & 1u); po[r][0] = (bf16_t)(ub >> 16); po[r] += sgn * 16 * DM; }
        }
#pragma unroll
        for (int kt8 = 0; kt8 < 8; ++kt8) {
            const float4 d = *(const float4*)&DEC[16 * kt8 + 4 * fq];
            f32x4 sc = Sacc[kt8]; sc[0] *= d.x; sc[1] *= d.y; sc[2] *= d.z; sc[3] *= d.w;
            u32x4 au; { const u32x2 t2 = *(const u32x2*)(KTp + (16 * kt8 + fr) * 20 + 4 * fq); au.x = t2.x; au.y = t2.y; au.z = 0u; au.w = 0u; }
            Sacc[kt8] = __builtin_amdgcn_mfma_f32_16x16x32_bf16(__builtin_bit_cast(bf16x8, au), vb, sc, 0, 0, 0);
        }
    }
    __syncthreads();
}

__device__ __forceinline__ void hyena_item(const Params& p, int c, unsigned char* shm) {
    int tid = tid_opaque();
    float2* buf = (float2*)shm;
    float* wsm = (float*)(shm + FFT_LDS_ELEMS * 8);
    float* red = wsm + 256;
    bf16_t* UT = (bf16_t*)(p.ws + WS_F);
    const float* hid3T = (const float*)(p.ws + WS_HID3);
    __syncthreads();
    if (tid < 256) { const int j = tid >> 2, q = tid & 3; wsm[tid] = p.in[I_FWO][j * 4096 + q * 1024 + c]; }
    __syncthreads();
    const float dlo = -3.0701134573253945f, dhi = -15.350567286626972f;
    const float delta = fabsf(dlo + (float)c * ((dhi - dlo) / 1023.0f));
    float g0[16], g1[16];
    float l0 = 0.f, l1 = 0.f;
    {
        const float* hp[16];
#pragma unroll
        for (int m = 0; m < 16; ++m) {
            const int idx = tid + 512 * m;
            int lag = (m < 8) ? idx : (8192 - idx);
            lag = (lag < 4096) ? lag : 4095;
            hp[m] = hid3T + lag;
            g0[m] = 0.f; g1[m] = 0.f;
        }
#pragma unroll 4
        for (int j = 0; j < 64; ++j) {
            const float4 wv = *(const float4*)&wsm[j * 4];
#pragma unroll
            for (int m = 0; m < 16; ++m) {
                const float hv = hp[m][j * 4096];
                g0[m] += hv * ((m < 8) ? wv.x : wv.y);
                g1[m] += hv * ((m < 8) ? wv.z : wv.w);
            }
        }
#pragma unroll
        for (int m = 0; m < 16; ++m) {
            const int idx = tid + 512 * m;
            const int lag = (m < 8) ? idx : (8192 - idx);
            const float win = (lag < 4096) ? __expf(-((float)lag * (1.0f / 4095.0f)) * delta) : 0.f;
            g0[m] *= win; g1[m] *= win;
            l0 += fabsf(g0[m]); l1 += fabsf(g1[m]);
        }
    }
    l0 = wave_sum(l0); l1 = wave_sum(l1);
    if ((tid & 63) == 0) { red[(tid >> 6) * 2] = l0; red[(tid >> 6) * 2 + 1] = l1; }
    __syncthreads();
    l0 = 0.f; l1 = 0.f;
#pragma unroll
    for (int i = 0; i < 8; ++i) { l0 += red[i * 2]; l1 += red[i * 2 + 1]; }
    const float d0 = p.in[I_HYD][c], d1 = p.in[I_HYD][1024 + c];
#pragma unroll 1
    for (int f = 0; f < 2; ++f) {
        float2 v[16], H[16];
        const float sc = 1.0f / ((f ? l1 : l0) * 8192.0f);
#pragma unroll
        for (int m = 0; m < 16; ++m) v[m] = make_float2((f ? g1[m] : g0[m]) * sc, 0.f);
        FFT_FWD_TO_PAIRS(v, buf, tid);
#pragma unroll
        for (int m = 0; m < 16; ++m) H[m] = v[m];
        __syncthreads();
        const float dd = f ? d1 : d0;
#pragma unroll 1
        for (int pr = 0; pr < 4; ++pr) {
            asm volatile("" : "+v"(tid));
            const int b0 = 2 * pr, b1 = b0 + 1;
            bf16_t* s0 = UT + ((size_t)(b0 * 3072 + (f ? 1024 : 0) + c)) * SEQ;
            bf16_t* s1 = UT + ((size_t)(b1 * 3072 + (f ? 1024 : 0) + c)) * SEQ;
            float in0[8], in1[8];
#pragma unroll
            for (int m = 0; m < 8; ++m) { in0[m] = bf2f(s0[tid + 512 * m]); in1[m] = bf2f(s1[tid + 512 * m]); v[m] = make_float2(in0[m], in1[m]); v[m + 8] = make_float2(0.f, 0.f); }
            FFT_FWD_TO_PAIRS(v, buf, tid);
#pragma unroll
            for (int m = 0; m < 16; ++m) v[m] = cmul(v[m], H[m]);
            bf16_t* x0 = UT + ((size_t)(b0 * 3072 + (f ? 2048 : 1024) + c)) * SEQ;
            bf16_t* x1 = UT + ((size_t)(b1 * 3072 + (f ? 2048 : 1024) + c)) * SEQ;
            bf16_t* o0 = f ? UT + ((size_t)(b0 * 3072 + c)) * SEQ : x0;
            bf16_t* o1 = f ? UT + ((size_t)(b1 * 3072 + c)) * SEQ : x1;
            bf16_t xm0[8], xm1[8];
#pragma unroll
            for (int m = 0; m < 8; ++m) { xm0[m] = x0[tid + 512 * m]; xm1[m] = x1[tid + 512 * m]; }
            FFT_INV_FROM_PAIRS(v, buf, tid);
            bf16_t ro0[8], ro1[8];
#pragma unroll
            for (int m = 0; m < 8; ++m) {
                ro0[m] = f2bf(bf2f(xm0[m]) * (v[m].x + dd * in0[m]));
                ro1[m] = f2bf(bf2f(xm1[m]) * (v[m].y + dd * in1[m]));
            }
#pragma unroll
            for (int m = 0; m < 8; ++m) { o0[tid + 512 * m] = ro0[m]; o1[tid + 512 * m] = ro1[m]; }
        }
    }
    __syncthreads();
}

__device__ __forceinline__ void phase_readout(const Params& p) {
    const int tid = tid_opaque(); const int lane = tid & 63, gwv = blockIdx.x * 8 + (tid >> 6), nw = gridDim.x * 8;
    bf16_t* MIX = (bf16_t*)(p.ws + WS_ABUF);
    const bf16_t* PX = (const bf16_t*)(p.ws + WS_C);
    const int col = (lane >> 3) * 128 + (lane & 7) * 16;
    for (int r = gwv; r < ML; r += nw) {
        bf16_t* mp = MIX + (size_t)r * DM + col;
        const bf16_t* gp = PX + (size_t)r * INC + 4096 + col;
        float o[16], g[16];
#pragma unroll
        for (int hh = 0; hh < 2; ++hh) {
            const u32x4 a = *(const u32x4*)(mp + hh * 8), bq = *(const u32x4*)(mp + 1024 + hh * 8), gg = *(const u32x4*)(gp + hh * 8);
            o[hh * 8 + 0] = bf_lo(a.x) + bf_lo(bq.x); o[hh * 8 + 1] = bf_hi(a.x) + bf_hi(bq.x); o[hh * 8 + 2] = bf_lo(a.y) + bf_lo(bq.y); o[hh * 8 + 3] = bf_hi(a.y) + bf_hi(bq.y);
            o[hh * 8 + 4] = bf_lo(a.z) + bf_lo(bq.z); o[hh * 8 + 5] = bf_hi(a.z) + bf_hi(bq.z); o[hh * 8 + 6] = bf_lo(a.w) + bf_lo(bq.w); o[hh * 8 + 7] = bf_hi(a.w) + bf_hi(bq.w);
            g[hh * 8 + 0] = bf_lo(gg.x); g[hh * 8 + 1] = bf_hi(gg.x); g[hh * 8 + 2] = bf_lo(gg.y); g[hh * 8 + 3] = bf_hi(gg.y);
            g[hh * 8 + 4] = bf_lo(gg.z); g[hh * 8 + 5] = bf_hi(gg.z); g[hh * 8 + 6] = bf_lo(gg.w); g[hh * 8 + 7] = bf_hi(gg.w);
        }
        float ss = 0.f;
#pragma unroll
        for (int i = 0; i < 16; ++i) ss += o[i] * o[i];
        ss += __shfl_xor(ss, 1); ss += __shfl_xor(ss, 2); ss += __shfl_xor(ss, 4);
        const float inv = rsqrtf(ss * (1.0f / 128.0f) + 1e-6f);
        float res[16];
#pragma unroll
        for (int i = 0; i < 16; ++i) res[i] = HG_SCALE * o[i] * inv * p.in[I_HGN][col + i] * siluf_(g[i]);
#pragma unroll
        for (int hh = 0; hh < 2; ++hh) {
            u32x4 w; w.x = cvt_pk_bf16(res[hh * 8 + 0], res[hh * 8 + 1]); w.y = cvt_pk_bf16(res[hh * 8 + 2], res[hh * 8 + 3]); w.z = cvt_pk_bf16(res[hh * 8 + 4], res[hh * 8 + 5]); w.w = cvt_pk_bf16(res[hh * 8 + 6], res[hh * 8 + 7]);
            *(u32x4*)(mp + hh * 8) = w;
        }
    }
}

__device__ __forceinline__ void phase_ytrans(const Params& p, unsigned char* shm) {
    const int tid = tid_opaque();
    float* tile = (float*)shm;
    const bf16_t* UT = (const bf16_t*)(p.ws + WS_F);
    bf16_t* MIX = (bf16_t*)(p.ws + WS_ABUF);
    for (int t = blockIdx.x; t < NB * 64 * 4; t += gridDim.x) {
        const int cg4 = t & 3, tb = (t >> 2) & 63, b = t >> 8;
        {
            const int cc = tid >> 3, t8 = (tid & 7) * 8;
            u32x4 w[4];
#pragma unroll
            for (int q = 0; q < 4; ++q) w[q] = *(const u32x4*)(UT + ((size_t)(b * 3072 + (cg4 * 4 + q) * 64 + cc)) * SEQ + tb * 64 + t8);
#pragma unroll
            for (int q = 0; q < 4; ++q) {
                float* tp = tile + q * (64 * 65) + cc * 65 + t8;
                tp[0] = bf_lo(w[q].x); tp[1] = bf_hi(w[q].x); tp[2] = bf_lo(w[q].y); tp[3] = bf_hi(w[q].y); tp[4] = bf_lo(w[q].z); tp[5] = bf_hi(w[q].z); tp[6] = bf_lo(w[q].w); tp[7] = bf_hi(w[q].w);
            }
        }
        __syncthreads();
#pragma unroll
        for (int q = 0; q < 4; ++q) {
            const int tt = tid >> 3, c8 = (tid & 7) * 8;
            const float* tq = tile + q * (64 * 65);
            float e[8];
#pragma unroll
            for (int j = 0; j < 8; ++j) e[j] = tq[(c8 + j) * 65 + tt];
            u32x4 w; w.x = cvt_pk_bf16(e[0], e[1]); w.y = cvt_pk_bf16(e[2], e[3]); w.z = cvt_pk_bf16(e[4], e[5]); w.w = cvt_pk_bf16(e[6], e[7]);
            *(u32x4*)(MIX + (size_t)(b * SEQ + tb * 64 + tt) * DM + 1024 + (cg4 * 4 + q) * 64 + c8) = w;
        }
        __syncthreads();
    }
}


#if DEBUG_CHECK
constexpr size_t WS_DBG = WS_END;
__device__ __forceinline__ float rbf(float x) { return bf2f(f2bf(x)); }
__device__ __forceinline__ void dbg_max(const Params& p, int slot, float e) { atomicMax((unsigned*)(p.ws + WS_DBG) + slot, __float_as_uint(e)); }
__device__ __forceinline__ unsigned hsh(unsigned x) { x ^= x >> 16; x *= 0x7feb352du; x ^= x >> 15; x *= 0x846ca68bu; x ^= x >> 16; return x; }
__device__ __forceinline__ float relerr(float got, float ref, float abs_floor) { return fabsf(got - ref) / (fabsf(ref) + abs_floor); }
__device__ __forceinline__ float naive_norm_elem(const float* src, const float* gw, const float* modrow, int sidx, int col) {
    float ss = 0.f; for (int k = 0; k < DM; ++k) ss += src[k] * src[k];
    const float inv = rsqrtf(ss / DM + 1e-6f);
    return src[col] * inv * gw[col] * (1.f + modrow[(sidx + 1) * DM + col]) + modrow[sidx * DM + col];
}
__device__ __forceinline__ void gemm_checks(const Params& p, int which) {
    const unsigned sid = blockIdx.x * 512 + threadIdx.x;
    const unsigned h1 = hsh(sid * 2u + 1u), h2 = hsh(sid * 2u + 2u);
    const float* mod = (const float*)(p.ws + WS_MOD);
    const bf16_t* ABUF = (const bf16_t*)(p.ws + WS_ABUF);
    const bf16_t* CB = (const bf16_t*)(p.ws + WS_C);
    const float* X1C = (const float*)(p.ws + WS_X1C);
    if (which == 1) {
        const int j = h1 % 9, col = h2 % MODC;
        float a = p.in[I_ADAB][col];
        for (int k = 0; k < DM; ++k) { const float cv = (j < 8) ? p.in[I_C][j * DM + k] : p.in[I_CCTX][k]; a += (cv / (1.f + expf(-cv))) * p.in[I_ADAW][(size_t)k * MODC + col]; }
        dbg_max(p, 0, relerr(mod[(size_t)j * MODC + col], a, 0.02f));
    } else if (which == 2 || which == 5 || which == 11) {
        const int nrows = (which == 11) ? ML : MT;
        const int row = h1 % nrows, col = h2 % DM;
        const float* src; const float* gw; int sidx;
        if (which == 2) { src = (row < ML) ? p.in[I_X] + (size_t)row * DM : p.in[I_CTX] + (size_t)(row - ML) * DM; gw = p.in[I_NFFN1]; sidx = 0; }
        else if (which == 5) { src = (row < ML) ? p.out + (size_t)row * DM : X1C + (size_t)(row - ML) * DM; gw = p.in[I_NMIX]; sidx = 3; }
        else { src = p.out + (size_t)row * DM; gw = p.in[I_NFFN2]; sidx = 6; }
        const float* modrow = mod + (size_t)((row < ML) ? (row >> 12) : 8) * MODC;
        const float ref = naive_norm_elem(src, gw, modrow, sidx, col);
        dbg_max(p, (which == 2) ? 1 : (which == 5) ? 4 : 7, relerr(bf2f(ABUF[(size_t)row * DM + col]), ref, 0.05f));
    } else if (which == 3 || which == 12) {
        const int nrows = (which == 12) ? ML : MT;
        const int row = h1 % nrows, hc = h2 % DFF;
        const float* w1 = p.in[(which == 3) ? I_F1W1 : I_F2W1]; const float* w3 = p.in[(which == 3) ? I_F1W3 : I_F2W3];
        float g = 0.f, u = 0.f;
        for (int k = 0; k < DM; ++k) { const float a = bf2f(ABUF[(size_t)row * DM + k]); g += a * rbf(w1[(size_t)k * DFF + hc]); u += a * rbf(w3[(size_t)k * DFF + hc]); }
        const float ref = (g / (1.f + expf(-g))) * u;
        dbg_max(p, (which == 3) ? 2 : 8, relerr(bf2f(CB[(size_t)row * DFF + hc]), ref, 0.05f));
    } else if (which == 4) {
        const int row = h1 % MT, col = h2 % DM;
        float d = 0.f;
        for (int k = 0; k < DFF; ++k) d += bf2f(CB[(size_t)row * DFF + k]) * rbf(p.in[I_F1W2][(size_t)k * DM + col]);
        const float src = (row < ML) ? p.in[I_X][(size_t)row * DM + col] : p.in[I_CTX][(size_t)(row - ML) * DM + col];
        const float gt = mod[(size_t)((row < ML) ? (row >> 12) : 8) * MODC + 2 * DM + col];
        const float ref = src + 0.5f * gt * d;
        const float got = (row < ML) ? p.out[(size_t)row * DM + col] : X1C[(size_t)(row - ML) * DM + col];
        dbg_max(p, 3, relerr(got, ref, 0.05f));
    } else if (which == 6) {
        const bool isc = (sid & 15) == 0;
        const int row = isc ? ML + (h1 % MC) : (h1 % ML), col = isc ? (h2 % 3072) : (h2 % INC);
        float d = 0.f;
        for (int k = 0; k < DM; ++k) d += bf2f(ABUF[(size_t)row * DM + k]) * rbf(p.in[I_WIN][(size_t)k * INC + col]);
        const float got = isc ? bf2f(((const bf16_t*)(p.ws + WS_PXC))[(size_t)(row - ML) * 3072 + col]) : bf2f(CB[(size_t)row * INC + col]);
        dbg_max(p, isc ? 6 : 5, relerr(got, d, 0.05f));
    }
}
#endif

#if ROWCHK
__device__ __forceinline__ float blk_max(float v, float* red) {
    const int tid = threadIdx.x;
    __syncthreads(); red[tid] = v; __syncthreads();
    float m = 0.f; for (int i = 0; i < 512; ++i) m = fmaxf(m, red[i]);
    __syncthreads();
    return m;
}
__device__ __forceinline__ float blk_sum(float v, float* red) {
    const int tid = threadIdx.x;
    __syncthreads(); red[tid] = v; __syncthreads();
    float m = 0.f; for (int i = 0; i < 512; ++i) m += red[i];
    __syncthreads();
    return m;
}
__device__ __forceinline__ void rc_norm(const float* src, const float* gw, const float* modb, int sidx, float* hrow, float* red) {
    const int tid = threadIdx.x;
    float ss = 0.f; for (int c = tid; c < DM; c += 512) ss += src[c] * src[c];
    __syncthreads(); red[tid] = ss; __syncthreads();
    float t = 0.f; for (int i = 0; i < 512; ++i) t += red[i];
    const float inv = 1.0f / sqrtf(t / DM + 1e-6f);
    for (int c = tid; c < DM; c += 512) hrow[c] = src[c] * inv * gw[c] * (1.f + modb[(sidx + 1) * DM + c]) + modb[sidx * DM + c];
    __syncthreads();
}
__device__ __forceinline__ void rc_ffn(const float* hrow, float* hid, const float* w1, const float* w3) {
    const int tid = threadIdx.x;
    for (int j = tid; j < DFF; j += 512) {
        float g = 0.f, u = 0.f;
        for (int k = 0; k < DM; ++k) { g += hrow[k] * w1[(size_t)k * DFF + j]; u += hrow[k] * w3[(size_t)k * DFF + j]; }
        hid[j] = (g / (1.f + expf(-g))) * u;
    }
    __syncthreads();
}
__device__ __forceinline__ void row_checks(const Params& p, int which, unsigned char* shm) {
    float* hrow = (float*)shm; float* hid = hrow + 2048; float* red = hid + 5632;
    const int tid = threadIdx.x, bid = blockIdx.x;
    const int row = bid * 128 + ((bid * 37) & 127);
    const float* modb = (const float*)(p.ws + WS_MOD) + (size_t)(row >> 12) * MODC;
    float* dbg = (float*)(p.ws + WS_MODP);
    float* save = dbg + 4096 + (size_t)bid * 2048;
    float e = 0.f, r2 = 0.f;
    if (which == 0 && bid >= 999) {
        const int rc = (bid - 192) * 32 + 7;
        const float* modc = (const float*)(p.ws + WS_MOD) + (size_t)8 * MODC;
        const float* X1Cc = (const float*)(p.ws + WS_X1C);
        rc_norm(p.in[I_CTX] + (size_t)rc * DM, p.in[I_NFFN1], modc, 0, hrow, red);
        rc_ffn(hrow, hid, p.in[I_F1W1], p.in[I_F1W3]);
        for (int c = tid; c < DM; c += 512) { float d = 0.f; for (int j = 0; j < DFF; ++j) d += hid[j] * p.in[I_F1W2][(size_t)j * DM + c];
            const float ref = p.in[I_CTX][(size_t)rc * DM + c] + 0.5f * modc[2 * DM + c] * d; { const float df = X1Cc[(size_t)rc * DM + c] - ref; e += df * df; r2 += ref * ref; } }
        e = blk_sum(e, red); r2 = blk_sum(r2, red); if (tid == 0) { dbg[5 * 256 + bid] = e; dbg[2048 + 5 * 256 + bid] = r2; }
    } else if (which == 1 && bid >= 999) {
        const int rc = (bid - 192) * 32 + 7;
        const float* modc = (const float*)(p.ws + WS_MOD) + (size_t)8 * MODC;
        rc_norm((const float*)(p.ws + WS_X1C) + (size_t)rc * DM, p.in[I_NMIX], modc, 3, hrow, red);
        const bf16_t* PXCc = (const bf16_t*)(p.ws + WS_PXC);
        for (int c = tid; c < 3072; c += 512) { float d = 0.f; for (int k = 0; k < DM; ++k) d += hrow[k] * p.in[I_WIN][(size_t)k * INC + c];
            { const float df = bf2f(PXCc[(size_t)rc * 3072 + c]) - d; e += df * df; r2 += d * d; } }
        e = blk_sum(e, red); r2 = blk_sum(r2, red); if (tid == 0) { dbg[7 * 256 + bid] = e; dbg[2048 + 7 * 256 + bid] = r2; }
    } else if (which == 0) {
        rc_norm(p.in[I_X] + (size_t)row * DM, p.in[I_NFFN1], modb, 0, hrow, red);
        rc_ffn(hrow, hid, p.in[I_F1W1], p.in[I_F1W3]);
        for (int c = tid; c < DM; c += 512) { float d = 0.f; for (int j = 0; j < DFF; ++j) d += hid[j] * p.in[I_F1W2][(size_t)j * DM + c];
            const float ref = p.in[I_X][(size_t)row * DM + c] + 0.5f * modb[2 * DM + c] * d; { const float df = p.out[(size_t)row * DM + c] - ref; e += df * df; r2 += ref * ref; } }
        e = blk_sum(e, red); r2 = blk_sum(r2, red); if (tid == 0) { dbg[0 * 256 + bid] = e; dbg[2048 + 0 * 256 + bid] = r2; }
    } else if (which == 1) {
        rc_norm(p.out + (size_t)row * DM, p.in[I_NMIX], modb, 3, hrow, red);
        const bf16_t* PX = (const bf16_t*)(p.ws + WS_C);
        for (int c = tid; c < INC; c += 512) { float d = 0.f; for (int k = 0; k < DM; ++k) d += hrow[k] * p.in[I_WIN][(size_t)k * INC + c];
            { const float df = bf2f(PX[(size_t)row * INC + c]) - d; e += df * df; r2 += d * d; } }
        e = blk_sum(e, red); r2 = blk_sum(r2, red); if (tid == 0) { dbg[1 * 256 + bid] = e; dbg[2048 + 1 * 256 + bid] = r2; }
    } else if (which == 2) {
        const bf16_t* MIX = (const bf16_t*)(p.ws + WS_ABUF);
        for (int c = tid; c < DM; c += 512) { float d = 0.f; for (int k = 0; k < DM; ++k) d += bf2f(MIX[(size_t)row * DM + k]) * p.in[I_WOUT][(size_t)k * DM + c];
            save[c] = p.out[(size_t)row * DM + c] + modb[5 * DM + c] * d; }
    } else if (which == 3) {
        for (int c = tid; c < DM; c += 512) { const float df = p.out[(size_t)row * DM + c] - save[c]; e += df * df; r2 += save[c] * save[c]; }
        e = blk_sum(e, red); r2 = blk_sum(r2, red); if (tid == 0) { dbg[2 * 256 + bid] = e; dbg[2048 + 2 * 256 + bid] = r2; }
        rc_norm(p.out + (size_t)row * DM, p.in[I_NFFN2], modb, 6, hrow, red);
        rc_ffn(hrow, hid, p.in[I_F2W1], p.in[I_F2W3]);
        for (int c = tid; c < DM; c += 512) { float d = 0.f; for (int j = 0; j < DFF; ++j) d += hid[j] * p.in[I_F2W2][(size_t)j * DM + c];
            save[c] = p.out[(size_t)row * DM + c] + 0.5f * modb[8 * DM + c] * d; }
    } else if (which == 4) {
        for (int c = tid; c < DM; c += 512) { const float df = p.out[(size_t)row * DM + c] - save[c]; e += df * df; r2 += save[c] * save[c]; }
        e = blk_sum(e, red); r2 = blk_sum(r2, red); if (tid == 0) { dbg[3 * 256 + bid] = e; dbg[2048 + 3 * 256 + bid] = r2; }
        float ss = 0.f; for (int c = tid; c < DM; c += 512) ss += p.out[(size_t)row * DM + c] * p.out[(size_t)row * DM + c];
        __syncthreads(); red[tid] = ss; __syncthreads();
        float t = 0.f; for (int i = 0; i < 512; ++i) t += red[i];
        const float inv = 1.0f / sqrtf(t / DM + 1e-6f);
        for (int c = tid; c < DM; c += 512) save[c] = p.out[(size_t)row * DM + c] * inv * p.in[I_FNORM][c];
    } else if (which == 5) {
        for (int c = tid; c < DM; c += 512) { const float df = p.out[(size_t)row * DM + c] - save[c]; e += df * df; r2 += save[c] * save[c]; }
        e = blk_sum(e, red); r2 = blk_sum(r2, red); if (tid == 0) { dbg[4 * 256 + bid] = e; dbg[2048 + 4 * 256 + bid] = r2; }
    } else if (which == 10) {
        const bf16_t* PX = (const bf16_t*)(p.ws + WS_C); const bf16_t* PXC = (const bf16_t*)(p.ws + WS_PXC); const bf16_t* MIX = (const bf16_t*)(p.ws + WS_ABUF);
        float* SL = (float*)shm;
        float* lbs = SL + 128 * 64;
        const int b = bid & 7, h = (bid >> 3) & 7, dir = (bid >> 6) & 1, v = (bid >> 7) * 64 + (tid & 63);
        if (tid < 128) { const int j = h * 128 + tid; lbs[tid] = sigmoidf_(p.in[I_LB][dir * 2048 + j] - p.in[I_LB][dir * 2048 + 1024 + j]); }
        __syncthreads();
        if (tid < 64) {
            for (int k = 0; k < 128; ++k) SL[k * 64 + tid] = 0.f;
            for (int step = 0; step < CTXL + SEQ; ++step) {
                const bool lat = step >= CTXL;
                const int q = lat ? step - CTXL : step;
                const bf16_t* rowp; int rw;
                if (!lat) { rw = b * CTXL + (dir ? CTXL - 1 - q : q); rowp = PXC + (size_t)rw * 3072; }
                else { rw = b * SEQ + (dir ? SEQ - 1 - q : q); rowp = PX + (size_t)rw * INC; }
                const float vv = bf2f(rowp[2048 + h * 128 + v]);
                float o = 0.f;
#pragma unroll 4
                for (int k = 0; k < 128; ++k) {
                    const float f = lbs[k] + (1.f - lbs[k]) * sigmoidf_(bf2f(rowp[dir * 1024 + h * 128 + k]));
                    const float sn = f * SL[k * 64 + tid] + (1.f - f) * vv;
                    SL[k * 64 + tid] = sn;
                    if (lat) o += sn * bf2f(rowp[3072 + h * 128 + k]) * 0.08838834764831845f;
                }
                if (lat) { const float got = bf2f(MIX[(size_t)rw * DM + dir * 1024 + h * 128 + v]); const float df = got - o; e += df * df; r2 += o * o; }
            }
        }
        e = blk_sum(e, red + 8192); r2 = blk_sum(r2, red + 8192); if (tid == 0) { dbg[528384 + bid] = e; dbg[528640 + bid] = r2; }
    } else if (which == 8) {
        const bf16_t* MIX = (const bf16_t*)(p.ws + WS_ABUF); const bf16_t* PX = (const bf16_t*)(p.ws + WS_C);
        for (int c = tid; c < 1024; c += 512) hrow[c] = bf2f(MIX[(size_t)row * DM + c]) + bf2f(MIX[(size_t)row * DM + 1024 + c]);
        __syncthreads();
        for (int c = tid; c < 1024; c += 512) { const int h0 = c & ~127; float ss = 0.f; for (int k = 0; k < 128; ++k) ss += hrow[h0 + k] * hrow[h0 + k];
            const float g = bf2f(PX[(size_t)row * INC + 4096 + c]);
            save[c] = hrow[c] / sqrtf(ss / 128.f + 1e-6f) * p.in[I_HGN][c] * (g / (1.f + expf(-g))); }
    } else if (which == 9) {
        const bf16_t* MIX = (const bf16_t*)(p.ws + WS_ABUF);
        for (int c = tid; c < 1024; c += 512) { const float df = bf2f(MIX[(size_t)row * DM + c]) - save[c]; e += df * df; r2 += save[c] * save[c]; }
        e = blk_sum(e, red); r2 = blk_sum(r2, red); if (tid == 0) { dbg[6 * 256 + bid] = e; dbg[2048 + 6 * 256 + bid] = r2; }
    } else if (which == 6) {
        if (bid == 0 && tid == 0) { float code = 0.f; for (int i = 0; i < 8; ++i) { float se = 0.f, sr = 0.f; for (int j = 0; j < 256; ++j) { const bool use = (i != 5 && i != 7); if (use) { se += dbg[i * 256 + j]; sr += dbg[2048 + i * 256 + j]; } } if (se > ROWCHK_TOL * sr) code += (float)(1 << i); } { for (int j = 0; j < 256; ++j) if (false && dbg[528384 + j] / (dbg[528640 + j] + 1e-20f) > HGCHK_TOL) code += 1.f; } p.out[0] += 10.f * code; }
    }
}
#endif

__global__ __launch_bounds__(512, 2) void mega(Params p) {
    extern __shared__ __attribute__((aligned(16))) unsigned char shm[];
    cg::grid_group grid = cg::this_grid();
    const int G = gridDim.x, bid = blockIdx.x;
    LAS unsigned char* lds = (LAS unsigned char*)shm;
    float* mod = (float*)(p.ws + WS_MOD);
    bf16_t* ABUF = (bf16_t*)(p.ws + WS_ABUF);
    bf16_t* CB = (bf16_t*)(p.ws + WS_C);
    float* X1C = (float*)(p.ws + WS_X1C);
    const bool split_ctx = (G >= 128) && (p.ph_lo == 0) && (p.ph_hi == NPH);
#if ROWCHK
    if (p.ph_lo >= 300) { row_checks(p, p.ph_lo - 300, shm); return; }
#endif
#if DEBUG_CHECK
    if (p.ph_lo >= 100 && p.ph_lo < 200) { gemm_checks(p, p.ph_lo - 100); return; }
    if (p.ph_lo == 200) {
        if (blockIdx.x == 0 && threadIdx.x == 0) { const float* d = (const float*)(p.ws + WS_DBG); float code = 0.f; for (int i = 0; i < 9; ++i) if (d[i] > 0.03f) code += (float)(1 << i); p.out[0] += 10.f * code; }
        return;
    }
#endif
#if DEBUG_CHECK
        if (p.ph_lo == 0 && blockIdx.x == 0 && threadIdx.x < 16) ((unsigned*)(p.ws + WS_DBG))[threadIdx.x] = 0u;
#endif
    unsigned long long tacc = 0ull, tprev = TSEL ? wall_clock64() : 0ull;
        PHASE_BEGIN(0) phase_prep(p, shm, split_ctx);
        PHASE_BEGIN(1) phase_modreduce(p);
        PHASE_BEGIN(2) phase_norm(p, p.in[I_X], p.in[I_CTX], 0, MT, p.in[I_NFFN1], 0, bid, G);
        PHASE_BEGIN(3) {
            pg8::Gemm g{ABUF, (const bf16_t*)(p.ws + WS_W13A), MT, 2 * DFF, DM};
            pg8::StaticOrder S; S.init(g.M, g.N, G, bid, 0);
            EpiSwiGLU E{CB};
            GEMM_RUN(3, g, S, E);
            if (split_ctx && G == 256 && bid >= 96) prep_tiles(p, shm, 8448, 10496, bid - 96, G - 96);
            else if (split_ctx && G != 256) prep_tiles(p, shm, 8448, 10496, bid, G);
        } PHASE_BEGIN(4) {
            pg8::Gemm g{CB, (const bf16_t*)(p.ws + WS_W2A), split_ctx ? ML : MT, DM, DFF};
            pg8::StaticOrder S; S.init(g.M, g.N, G, bid, 0);
            EpiRes E{p.in[I_X], p.out, p.in[I_CTX], X1C, mod + 2 * DM, 0.5f};
            GEMM_RUN(4, g, S, E);
        } PHASE_BEGIN(5) {
            if (!split_ctx) phase_norm(p, p.out, X1C, 0, MT, p.in[I_NMIX], 3, bid, G);
            else if (bid < 64) {
                pg8::Gemm g{CB + (size_t)ML * DFF, (const bf16_t*)(p.ws + WS_W2A), MC, DM, DFF};
                pg8::StaticOrder S; S.init(g.M, g.N, 64, bid, 0);
                EpiRes E{p.in[I_CTX], X1C, nullptr, nullptr, mod + 2 * DM, 0.5f, 8};
                GEMM_RUN(4, g, S, E);
            } else { phase_norm(p, p.out, X1C, 0, ML, p.in[I_NMIX], 3, bid - 64, G - 64); prep_tiles(p, shm, 19200, 22016, bid - 64, G - 64); }
        }
        PHASE_BEGIN(6) {
            if (split_ctx) { phase_norm(p, p.out, X1C, ML, MT, p.in[I_NMIX], 3, bid, G); grid.sync(); }
            pg8::Gemm g{ABUF, (const bf16_t*)(p.ws + WS_WIN), ML, INC, DM};
            pg8::StaticOrder S; S.init(g.M, g.N, G, bid, 96);
            EpiBf16 E{CB, INC, (bf16_t*)(p.ws + WS_PXC), 3072};
            GEMM_RUN(6, g, S, E);
            if (split_ctx && G == 256 && bid >= 96) prep_tiles(p, shm, 12544, 13568, bid - 96, G - 96);
            else if (split_ctx && G != 256) prep_tiles(p, shm, 12544, 13568, bid, G);
        } PHASE_BEGIN(7) {
#if HG_MFMA
            if (G >= 256) { if (bid < 128) hgrn_mfma_item(p, bid, shm); else { phase_shortconv(p, shm, bid - 128, G - 128); if (split_ctx) prep_tiles(p, shm, 13568, 19200, bid - 128, G - 128); } }
            else if (split_ctx) {   phase_shortconv(p, shm, bid, G); prep_tiles(p, shm, 13568, 19200, bid, G); for (int it = bid; it < 128; it += G) hgrn_mfma_item(p, it, shm); }
            else { phase_shortconv(p, shm, bid, G); for (int it = bid; it < 128; it += G) hgrn_mfma_item(p, it, shm); }
#else
            phase_shortconv(p, shm, bid, G);
            for (int it = bid; it < 256; it += G) hgrn_item(p, it, shm);
#endif
        } PHASE_BEGIN(8) {
            for (int c = bid; c < 1024; c += G) hyena_item(p, c, shm);
            phase_readout(p);
        } PHASE_BEGIN(9) phase_ytrans(p, shm);
        PHASE_BEGIN(10) {
            pg8::Gemm g{ABUF, (const bf16_t*)(p.ws + WS_WOUT), ML, DM, DM};
            pg8::StaticOrder S; S.init(g.M, g.N, G, bid, 0);
            EpiRes E{p.out, p.out, nullptr, nullptr, mod + 5 * DM, 1.0f};
            GEMM_RUN(10, g, S, E);
        } PHASE_BEGIN(11) phase_norm(p, p.out, nullptr, 0, ML, p.in[I_NFFN2], 6, bid, G);
        PHASE_BEGIN(12) {
            pg8::Gemm g{ABUF, (const bf16_t*)(p.ws + WS_W13B), ML, 2 * DFF, DM};
            pg8::StaticOrder S; S.init(g.M, g.N, G, bid, 0);
            EpiSwiGLU E{CB};
            GEMM_RUN(12, g, S, E);
        } PHASE_BEGIN(13) {
            pg8::Gemm g{CB, (const bf16_t*)(p.ws + WS_W2B), ML, DM, DFF};
            pg8::StaticOrder S; S.init(g.M, g.N, G, bid, 0);
            EpiRes E{p.out, p.out, nullptr, nullptr, mod + 8 * DM, 0.5f};
            GEMM_RUN(13, g, S, E);
        } PHASE_BEGIN(14) phase_final_norm(p);
    if (TSEL) { const unsigned long long now_ = wall_clock64(); if (TSEL & (1 << 14)) tacc += now_ - tprev; if (blockIdx.x == 0 && threadIdx.x == 0) p.out[4096 * 2048 + 5] += (float)tacc * 0.0001f; }
}

extern "C" void kernel_launch(void* const* d_in, const int* in_sizes, int n_in, void* d_out, int out_size, void* d_ws, size_t ws_size, hipStream_t stream) {
    static int grid_blocks = 0;
    if (grid_blocks == 0) {
        if (n_in != 31 || out_size != ML * DM || ws_size < WS_END + 64) { fprintf(stderr, "kernel_launch: unexpected shapes (n_in %d out %d ws %zu need %zu)\n", n_in, out_size, ws_size, (size_t)WS_END); grid_blocks = -1; return; }
        int dev = 0, cus = 0, per_cu = 0;
        hipGetDevice(&dev);
        hipDeviceGetAttribute(&cus, hipDeviceAttributeMultiprocessorCount, dev);
        if (hipFuncSetAttribute((const void*)mega, hipFuncAttributeMaxDynamicSharedMemorySize, LDS_BYTES) != hipSuccess) { fprintf(stderr, "kernel_launch: hipFuncSetAttribute failed\n"); grid_blocks = -1; return; }
        if (hipOccupancyMaxActiveBlocksPerMultiprocessor(&per_cu, (const void*)mega, 512, LDS_BYTES) != hipSuccess || per_cu < 1) { fprintf(stderr, "kernel_launch: occupancy query failed (%d)\n", per_cu); per_cu = 1; (void)hipGetLastError(); }
        grid_blocks = cus * per_cu;
    }
    if (grid_blocks < 0) return;
    Params p;
    memset(&p, 0, sizeof(p));
    for (int i = 0; i < 31; ++i) p.in[i] = (const float*)d_in[i];
    p.out = (float*)d_out; p.ws = (unsigned char*)d_ws;
#if MULTI_LAUNCH
    for (int ph = 0; ph < NPH; ++ph) {
        p.ph_lo = ph; p.ph_hi = ph + 1;
        hipLaunchKernelGGL(mega, dim3(grid_blocks), dim3(512), LDS_BYTES, stream, p);
#if ROWCHK
        { const int w = (ph == 4) ? 0 : (ph == 6) ? 1 : (ph == 7) ? 8 : (ph == 8) ? 9 : (ph == 9) ? 2 : (ph == 10) ? 3 : (ph == 13) ? 4 : (ph == 14) ? 5 : -1;
          if (w >= 0) { p.ph_lo = 300 + w; p.ph_hi = 301 + w; hipLaunchKernelGGL(mega, dim3(256), dim3(512), LDS_BYTES, stream, p); }
          if (ph == 7) { p.ph_lo = 310; p.ph_hi = 311; hipLaunchKernelGGL(mega, dim3(256), dim3(512), LDS_BYTES, stream, p); }
          if (ph == 14) { p.ph_lo = 306; p.ph_hi = 307; hipLaunchKernelGGL(mega, dim3(256), dim3(512), LDS_BYTES, stream, p); } }
#endif
#if DEBUG_CHECK
        if (DBG_MASK & (1 << ph)) { p.ph_lo = 100 + ph; p.ph_hi = 101 + ph; hipLaunchKernelGGL(mega, dim3(grid_blocks), dim3(512), LDS_BYTES, stream, p); }
        if (ph == NPH - 1) { p.ph_lo = 200; p.ph_hi = 201 + DBG_SLOT; hipLaunchKernelGGL(mega, dim3(grid_blocks), dim3(512), LDS_BYTES, stream, p); }
#endif
    }
#else
    p.ph_lo = 0; p.ph_hi = NPH;
    void* args[] = {&p};
    hipError_t e = hipLaunchCooperativeKernel((const void*)mega, dim3(grid_blocks), dim3(512), args, LDS_BYTES, stream);
    if (e != hipSuccess) fprintf(stderr, "cooperative launch failed: %s (grid %d)\n", hipGetErrorString(e), grid_blocks);
#endif
}
```
